# Optimizing an MI355X kernel written in HIP

```python
import math
import jax
import jax.numpy as jnp
from jax import lax
import numpy as np

D_MODEL = 1024
BATCH = 4
SEQ = 4096
DEPTH = 4

N_HEADS_RWKV = 8
HEAD_RWKV = 64
RWKV_WIDTH = N_HEADS_RWKV * HEAD_RWKV
LORA_W = 64
LORA_A = 64
LORA_G = 128
RWKV_GN_EPS = 64e-5

N_HEADS_NSA = 8
N_KV_GROUPS = 2
HEADS_PER_GROUP = N_HEADS_NSA // N_KV_GROUPS
HEAD_NSA = 64
NSA_Q_WIDTH = N_HEADS_NSA * HEAD_NSA
NSA_KV_WIDTH = N_KV_GROUPS * HEAD_NSA
CMP_BLOCK = 32
CMP_STRIDE = 16
CMP_HIDDEN = 128
SEL_BLOCK = 64
N_SELECT = 16
WINDOW = 512
Q_BLOCK = 128
N_BAND = WINDOW // Q_BLOCK + 1
NEG_INF = -1e30
FORCED_SCORE = 1e4

NUM_BUCKETS = 32
MAX_DISTANCE = 1024

N_GROUPS = 4
EXPERTS_PER_GROUP = 8
N_EXPERTS = N_GROUPS * EXPERTS_PER_GROUP
TOP_K_INNER = 2
D_EXPERT = 512
MOE_BLOCK = 128

ALPHA = (2 * DEPTH) ** 0.25
BETA = (8 * DEPTH) ** -0.25
LN_EPS = 1e-5

SHIFT_SPLITS = (RWKV_WIDTH, RWKV_WIDTH, RWKV_WIDTH, LORA_W, LORA_A, LORA_G)
SHIFT_WIDTH = 3 * RWKV_WIDTH + LORA_W + LORA_A + LORA_G
REST_SPLITS = (NSA_Q_WIDTH,) + (NSA_KV_WIDTH,) * 6 + (3 * N_HEADS_NSA, D_MODEL, D_MODEL)
IN_WIDTH = SHIFT_WIDTH + NSA_Q_WIDTH + 6 * NSA_KV_WIDTH + 3 * N_HEADS_NSA + 2 * D_MODEL

kernel_name = 'hybrid_rwkv7_nsa_hmoe_deepnorm'


def _split_cols(z, sizes):
    return jnp.split(z, np.cumsum(sizes)[:-1].tolist(), axis=-1)


def _layer_norm(x, g, b, eps=LN_EPS):
    xf = x.astype(jnp.float32)
    mu = jnp.mean(xf, axis=-1, keepdims=True)
    var = jnp.mean(jnp.square(xf - mu), axis=-1, keepdims=True)
    return ((xf - mu) * lax.rsqrt(var + eps) * g + b).astype(x.dtype)


def _t5_bucket(dist):
    n = jnp.maximum(dist, 0)
    max_exact = NUM_BUCKETS // 2
    nf = jnp.maximum(n, 1).astype(jnp.float32)
    large = max_exact + (jnp.log(nf / max_exact) / math.log(MAX_DISTANCE / max_exact)
                         * (NUM_BUCKETS - max_exact)).astype(jnp.int32)
    large = jnp.minimum(large, NUM_BUCKETS - 1)
    return jnp.where(n < max_exact, n, large)


def _bias_from_buckets(rel_bias, bucket):
    b = jnp.moveaxis(rel_bias.astype(jnp.float32)[bucket], -1, 0)
    return b.reshape((N_KV_GROUPS, HEADS_PER_GROUP) + bucket.shape)


def _nsa_positional(rel_bias, seq):
    n_cmp = seq // CMP_STRIDE - CMP_BLOCK // CMP_STRIDE + 1
    n_sel_blocks = seq // SEL_BLOCK
    t = jnp.arange(seq)[:, None]
    c = jnp.arange(n_cmp)[None, :]
    d_cmp = t - (c * CMP_STRIDE + CMP_BLOCK - 1)
    mask_cmp = d_cmp >= 0
    bias_cmp = _bias_from_buckets(rel_bias, _t5_bucket(d_cmp))
    qo = jnp.arange(Q_BLOCK)[:, None]
    m = jnp.arange(WINDOW + Q_BLOCK)[None, :]
    d_win = qo + WINDOW - m
    bias_win = _bias_from_buckets(rel_bias, _t5_bucket(d_win))
    blk = jnp.arange(seq // Q_BLOCK)[:, None, None]
    mask_win = (d_win >= 0) & (d_win < WINDOW) & (blk * Q_BLOCK - WINDOW + m >= 0)
    cs = jnp.arange(n_cmp)[:, None] * CMP_STRIDE
    ss = jnp.arange(n_sel_blocks)[None, :] * SEL_BLOCK
    overlap = jnp.clip(jnp.minimum(cs + CMP_BLOCK, ss + SEL_BLOCK) - jnp.maximum(cs, ss), 0, None)
    cmp_to_sel = overlap.astype(jnp.float32) / CMP_BLOCK
    return bias_cmp, mask_cmp, bias_win, mask_win, cmp_to_sel


def _rwkv7_time_mix(r, k, v, wl, al, gl, w0, w2, a0, a2, g2, k_k, k_a, r_k, ln_g, ln_b):
    B, S, C = r.shape
    H, N = N_HEADS_RWKV, HEAD_RWKV
    f32 = jnp.float32
    logw = -jax.nn.softplus(-(w0 + jnp.tanh(wl) @ w2).astype(f32)) - 0.5
    decay = jnp.exp(-jnp.exp(logw))
    a = jax.nn.sigmoid((a0 + al @ a2).astype(f32))
    g = jax.nn.sigmoid(gl) @ g2
    r, k, v = r.astype(f32), k.astype(f32), v.astype(f32)
    heads = lambda t: t.reshape(B, S, H, N)
    kk = heads(k * k_k)
    kk = kk / jnp.maximum(jnp.linalg.norm(kk, axis=-1, keepdims=True), 1e-12)
    k = k * (1.0 + (a - 1.0) * k_a)
    rh, kh, vh, ah, wh = heads(r), heads(k), heads(v), heads(a), heads(decay)

    def step(state, inp):
        r_t, w_t, k_t, v_t, kk_t, a_t = inp
        sa = jnp.einsum('bhvk,bhk->bhv', state, -kk_t)
        state = (state * w_t[:, :, None, :] + sa[..., None] * (kk_t * a_t)[:, :, None, :]
                 + v_t[..., None] * k_t[:, :, None, :])
        return state, jnp.einsum('bhvk,bhk->bhv', state, r_t)

    xs = tuple(jnp.moveaxis(t, 1, 0) for t in (rh, wh, kh, vh, kk, ah))
    _, y = lax.scan(step, jnp.zeros((B, H, N, N), f32), xs)
    y = jnp.moveaxis(y, 0, 1)
    mu = jnp.mean(y, axis=-1, keepdims=True)
    var = jnp.mean(jnp.square(y - mu), axis=-1, keepdims=True)
    y = ((y - mu) * lax.rsqrt(var + RWKV_GN_EPS)).reshape(B, S, C) * ln_g + ln_b
    bonus = jnp.sum(rh * kh * r_k, axis=-1, keepdims=True) * vh
    return (y + bonus.reshape(B, S, C)) * g


def _compress(t, pe, w1, w2):
    B, S, G, Dh = t.shape
    rep = CMP_BLOCK // CMP_STRIDE
    nc = S // CMP_STRIDE - rep + 1
    sub = t.reshape(B, S // CMP_STRIDE, CMP_STRIDE, G, Dh)
    blk = jnp.concatenate([sub[:, j:j + nc] for j in range(rep)], axis=2)
    blk = blk + pe[:, None, :]
    blk = blk.transpose(0, 1, 3, 2, 4).reshape(B, nc, G, CMP_BLOCK * Dh)
    out = jax.nn.gelu(blk @ w1) @ w2
    return out.transpose(0, 2, 1, 3)


def _nsa_attention(q, k_cmp, v_cmp, k_slc, v_slc, k_win, v_win, gate_logits,
                   pe_k, w1_k, w2_k, pe_v, w1_v, w2_v, rel_bias, pos):
    bias_cmp, mask_cmp, bias_win, mask_win, cmp_to_sel = pos
    B, S, _ = q.shape
    G, Hg, Dh = N_KV_GROUPS, HEADS_PER_GROUP, HEAD_NSA
    f32 = jnp.float32
    scale = HEAD_NSA ** -0.5
    qh = q.reshape(B, S, G, Hg, Dh).transpose(0, 2, 3, 1, 4)
    kv = lambda t: t.reshape(B, S, G, Dh).transpose(0, 2, 1, 3)

    kc = _compress(k_cmp.reshape(B, S, G, Dh), pe_k, w1_k, w2_k)
    vc = _compress(v_cmp.reshape(B, S, G, Dh), pe_v, w1_v, w2_v)
    lg = jnp.einsum('bghqd,bgcd->bghqc', qh, kc).astype(f32) * scale + bias_cmp
    p_cmp = jax.nn.softmax(jnp.where(mask_cmp, lg, NEG_INF), axis=-1) * mask_cmp
    o_cmp = jnp.einsum('bghqc,bgcd->bghqd', p_cmp, vc.astype(f32))

    n_sel_blocks = S // SEL_BLOCK
    n_sel = min(N_SELECT, n_sel_blocks)
    score = jnp.einsum('bgqc,cj->bgqj', jnp.sum(p_cmp, axis=2), cmp_to_sel)
    t = jnp.arange(S)[:, None]
    j = jnp.arange(n_sel_blocks)[None, :]
    cur = t // SEL_BLOCK
    forced = (j == 0) | (j == cur) | (j == cur - 1)
    score = jnp.where(forced, FORCED_SCORE, jnp.where(j <= cur, score, -1.0))
    _, sel_idx = lax.top_k(score, n_sel)
    ks_b = kv(k_slc).reshape(B, G, n_sel_blocks, SEL_BLOCK, Dh)
    vs_b = kv(v_slc).reshape(B, G, n_sel_blocks, SEL_BLOCK, Dh)
    table = rel_bias.astype(f32).reshape(NUM_BUCKETS, G, Hg).transpose(1, 2, 0)
    bi = jnp.arange(B)[:, None, None, None]
    gi = jnp.arange(G)[None, :, None, None]
    gi6 = jnp.arange(G)[None, :, None, None, None, None]
    hi6 = jnp.arange(Hg)[None, None, :, None, None, None]

    def sel_chunk(c):
        t0 = c * Q_BLOCK
        qc = lax.dynamic_slice_in_dim(qh, t0, Q_BLOCK, axis=3)
        ic = lax.dynamic_slice_in_dim(sel_idx, t0, Q_BLOCK, axis=2)
        kg = ks_b[bi, gi, ic]
        vg = vs_b[bi, gi, ic]
        kpos = ic[..., None] * SEL_BLOCK + jnp.arange(SEL_BLOCK)
        dist = (t0 + jnp.arange(Q_BLOCK))[:, None, None] - kpos
        bias = table[gi6, hi6, _t5_bucket(dist)[:, :, None]]
        lgs = jnp.einsum('bghqd,bgqnld->bghqnl', qc, kg).astype(f32) * scale + bias
        lgs = jnp.where((dist >= 0)[:, :, None], lgs, NEG_INF)
        p = jax.nn.softmax(lgs.reshape(B, G, Hg, Q_BLOCK, n_sel * SEL_BLOCK), axis=-1).reshape(lgs.shape)
        return jnp.einsum('bghqnl,bgqnld->bghqd', p, vg.astype(f32))

    o_slc = lax.map(sel_chunk, jnp.arange(S // Q_BLOCK))
    o_slc = jnp.moveaxis(o_slc, 0, 3).reshape(B, G, Hg, S, Dh)

    nb = S // Q_BLOCK

    def band(t):
        tp = jnp.pad(kv(t), ((0, 0), (0, 0), (WINDOW, 0), (0, 0))).reshape(B, G, nb + N_BAND - 1, Q_BLOCK, Dh)
        return jnp.concatenate([tp[:, :, o:o + nb] for o in range(N_BAND)], axis=3)

    kw_b, vw_b = band(k_win), band(v_win)
    qb = qh.reshape(B, G, Hg, nb, Q_BLOCK, Dh)
    lgw = jnp.einsum('bghnqd,bgnkd->bghnqk', qb, kw_b).astype(f32) * scale + bias_win[:, :, None]
    pw = jax.nn.softmax(jnp.where(mask_win, lgw, NEG_INF), axis=-1)
    o_win = jnp.einsum('bghnqk,bgnkd->bghnqd', pw, vw_b.astype(f32)).reshape(B, G, Hg, S, Dh)

    gates = jax.nn.sigmoid(gate_logits.astype(f32)).reshape(B, S, G, Hg, 3).transpose(0, 2, 3, 1, 4)
    o = gates[..., 0:1] * o_cmp + gates[..., 1:2] * o_slc + gates[..., 2:3] * o_win
    return o.transpose(0, 3, 1, 2, 4).reshape(B, S, NSA_Q_WIDTH)


def _token_mixer(x, w_in, shift_mu, rw_w0, rw_w2, rw_a0, rw_a2, rw_g2, rw_kk, rw_ka, rw_rk,
                 rw_ln_g, rw_ln_b, cmp_pe_k, cmp_w1_k, cmp_w2_k, cmp_pe_v, cmp_w1_v, cmp_w2_v,
                 w_up_rwkv, w_up_nsa, w_out, rel_bias, pos):
    z = x @ w_in
    z_shift, z_rest = z[..., :SHIFT_WIDTH], z[..., SHIFT_WIDTH:]
    z_prev = jnp.pad(z_shift, ((0, 0), (1, 0), (0, 0)))[:, :-1]
    z_shift = z_shift + (z_prev - z_shift) * shift_mu
    r, k, v, wl, al, gl = _split_cols(z_shift, SHIFT_SPLITS)
    q, kc, vc, ks, vs, kw, vw, nsa_g, g_rw, g_nsa = _split_cols(z_rest, REST_SPLITS)
    y_rw = _rwkv7_time_mix(r, k, v, wl, al, gl, rw_w0, rw_w2, rw_a0, rw_a2, rw_g2,
                           rw_kk, rw_ka, rw_rk, rw_ln_g, rw_ln_b).astype(x.dtype)
    y_nsa = _nsa_attention(q, kc, vc, ks, vs, kw, vw, nsa_g, cmp_pe_k, cmp_w1_k, cmp_w2_k,
                           cmp_pe_v, cmp_w1_v, cmp_w2_v, rel_bias, pos).astype(x.dtype)
    merged = jax.nn.sigmoid(g_rw) * (y_rw @ w_up_rwkv) + jax.nn.sigmoid(g_nsa) * (y_nsa @ w_up_nsa)
    return merged @ w_out


def _hier_moe(x, wg, bg, we, be, w1, w3, w2):
    B, S, D = x.shape
    N = B * S
    f32 = jnp.float32
    xf = x.reshape(N, D)
    g_prob = jax.nn.softmax((xf @ wg + bg).astype(f32), axis=-1)
    grp = jnp.argmax(g_prob, axis=-1)
    p_grp = jnp.take_along_axis(g_prob, grp[:, None], axis=1)[:, 0]
    e_logits = (xf @ we + be).astype(f32).reshape(N, N_GROUPS, EXPERTS_PER_GROUP)
    e_logits = jnp.take_along_axis(e_logits, grp[:, None, None], axis=1)[:, 0]
    top_v, top_i = lax.top_k(e_logits, TOP_K_INNER)
    top_w = jax.nn.softmax(top_v, axis=-1) * p_grp[:, None]
    eid = (grp[:, None] * EXPERTS_PER_GROUP + top_i).reshape(-1).astype(jnp.int32)
    slot_w = top_w.reshape(-1)
    slot_tok = jnp.repeat(jnp.arange(N, dtype=jnp.int32), TOP_K_INNER)
    n_slots = N * TOP_K_INNER
    order = jnp.argsort(eid)
    eid_s = eid[order]
    counts = jax.ops.segment_sum(jnp.ones_like(eid), eid, num_segments=N_EXPERTS)
    starts = jnp.cumsum(counts) - counts
    pcounts = (counts + MOE_BLOCK - 1) // MOE_BLOCK * MOE_BLOCK
    pends = jnp.cumsum(pcounts)
    pstarts = pends - pcounts
    dest = pstarts[eid_s] + (jnp.arange(n_slots) - starts[eid_s])
    n_rows = n_slots + N_EXPERTS * MOE_BLOCK
    n_blk = n_rows // MOE_BLOCK
    row_tok = jnp.full((n_rows,), N, jnp.int32).at[dest].set(slot_tok[order])
    row_w = jnp.zeros((n_rows,), f32).at[dest].set(slot_w[order])
    blk_exp = jnp.minimum(jnp.sum(jnp.arange(n_blk)[:, None] * MOE_BLOCK >= pends[None, :], axis=1),
                          N_EXPERTS - 1)
    xpad = jnp.concatenate([xf, jnp.zeros((1, D), xf.dtype)], axis=0)
    xs = xpad[row_tok].reshape(n_blk, MOE_BLOCK, D)

    def expert_block(args):
        xb, e = args
        h = jax.nn.silu(xb @ w1[e]) * (xb @ w3[e])
        return h @ w2[e]

    ys = lax.map(expert_block, (xs, blk_exp)).reshape(n_rows, D)
    out = jnp.zeros((N + 1, D), f32).at[row_tok].add(ys.astype(f32) * row_w[:, None])
    return out[:N].reshape(B, S, D).astype(x.dtype)


def setup_inputs(seed: int = 0) -> dict:
    key = jax.random.key(seed)
    keys = iter(jax.random.split(key, 48))
    f32 = jnp.float32

    def nrm(shape, scale):
        return jax.random.normal(next(keys), shape, f32) * scale

    L, D, C = DEPTH, D_MODEL, RWKV_WIDTH
    return {
        'x': nrm((BATCH, SEQ, D), 1.0),
        'rel_bias': nrm((NUM_BUCKETS, N_HEADS_NSA), 0.3),
        'w_in': nrm((L, D, IN_WIDTH), D ** -0.5),
        'shift_mu': jax.random.uniform(next(keys), (L, SHIFT_WIDTH), f32),
        'rw_w0': jnp.linspace(-6.0, -1.0, C, dtype=f32)[None, :] + nrm((L, C), 0.1),
        'rw_w2': nrm((L, LORA_W, C), 0.1 * LORA_W ** -0.5),
        'rw_a0': nrm((L, C), 0.1),
        'rw_a2': nrm((L, LORA_A, C), 0.3 * LORA_A ** -0.5),
        'rw_g2': nrm((L, LORA_G, C), LORA_G ** -0.5),
        'rw_kk': 0.85 + nrm((L, C), 0.05),
        'rw_ka': 1.0 + nrm((L, C), 0.05),
        'rw_rk': nrm((L, N_HEADS_RWKV, HEAD_RWKV), 0.1),
        'rw_ln_g': 1.0 + nrm((L, C), 0.02),
        'rw_ln_b': nrm((L, C), 0.02),
        'cmp_pe_k': nrm((L, CMP_BLOCK, HEAD_NSA), 0.1),
        'cmp_w1_k': nrm((L, CMP_BLOCK * HEAD_NSA, CMP_HIDDEN), (CMP_BLOCK * HEAD_NSA) ** -0.5),
        'cmp_w2_k': nrm((L, CMP_HIDDEN, HEAD_NSA), CMP_HIDDEN ** -0.5),
        'cmp_pe_v': nrm((L, CMP_BLOCK, HEAD_NSA), 0.1),
        'cmp_w1_v': nrm((L, CMP_BLOCK * HEAD_NSA, CMP_HIDDEN), (CMP_BLOCK * HEAD_NSA) ** -0.5),
        'cmp_w2_v': nrm((L, CMP_HIDDEN, HEAD_NSA), CMP_HIDDEN ** -0.5),
        'w_up_rwkv': nrm((L, C, D), C ** -0.5),
        'w_up_nsa': nrm((L, NSA_Q_WIDTH, D), NSA_Q_WIDTH ** -0.5),
        'w_out': nrm((L, D, D), BETA * D ** -0.5),
        'ln1_g': 1.0 + nrm((L, D), 0.02),
        'ln1_b': nrm((L, D), 0.02),
        'router_group_w': nrm((L, D, N_GROUPS), D ** -0.5),
        'router_group_b': nrm((L, N_GROUPS), 0.01),
        'router_expert_w': nrm((L, D, N_EXPERTS), D ** -0.5),
        'router_expert_b': nrm((L, N_EXPERTS), 0.01),
        'exp_w1': nrm((L, N_EXPERTS, D, D_EXPERT), D ** -0.5),
        'exp_w3': nrm((L, N_EXPERTS, D, D_EXPERT), D ** -0.5),
        'exp_w2': nrm((L, N_EXPERTS, D_EXPERT, D), BETA * D_EXPERT ** -0.5),
        'ln2_g': 1.0 + nrm((L, D), 0.02),
        'ln2_b': nrm((L, D), 0.02),
    }


def reference(x, rel_bias, w_in, shift_mu, rw_w0, rw_w2, rw_a0, rw_a2, rw_g2, rw_kk, rw_ka, rw_rk,
              rw_ln_g, rw_ln_b, cmp_pe_k, cmp_w1_k, cmp_w2_k, cmp_pe_v, cmp_w1_v, cmp_w2_v,
              w_up_rwkv, w_up_nsa, w_out, ln1_g, ln1_b, router_group_w, router_group_b,
              router_expert_w, router_expert_b, exp_w1, exp_w3, exp_w2, ln2_g, ln2_b):
    pos = _nsa_positional(rel_bias, x.shape[1])
    for l in range(DEPTH):
        h = _token_mixer(x, w_in[l], shift_mu[l], rw_w0[l], rw_w2[l], rw_a0[l], rw_a2[l], rw_g2[l],
                         rw_kk[l], rw_ka[l], rw_rk[l], rw_ln_g[l], rw_ln_b[l],
                         cmp_pe_k[l], cmp_w1_k[l], cmp_w2_k[l], cmp_pe_v[l], cmp_w1_v[l], cmp_w2_v[l],
                         w_up_rwkv[l], w_up_nsa[l], w_out[l], rel_bias, pos)
        x = _layer_norm(ALPHA * x + h, ln1_g[l], ln1_b[l])
        h = _hier_moe(x, router_group_w[l], router_group_b[l], router_expert_w[l], router_expert_b[l],
                      exp_w1[l], exp_w3[l], exp_w2[l])
        x = _layer_norm(ALPHA * x + h, ln2_g[l], ln2_b[l])
    return x
```

```cpp
#include <hip/hip_runtime.h>
#include <cstdio>
#include <cstdint>

constexpr int WSLOT_OFF = 135168 + 1600;
__device__ __forceinline__ int tid_l() {
    const unsigned slot = (unsigned)__builtin_amdgcn_s_getreg((6 << 11) | 4) & 63u;
    extern __shared__ __attribute__((aligned(16))) unsigned char lds_all[];
    int wv = ((const __attribute__((address_space(3))) int*)((__attribute__((address_space(3))) unsigned char*)lds_all + WSLOT_OFF))[slot];
    wv = __builtin_amdgcn_readfirstlane(wv);
    int ln; asm volatile("v_mbcnt_lo_u32_b32 %0, -1, 0\n\tv_mbcnt_hi_u32_b32 %0, -1, %0" : "=v"(ln));
    int t = wv * 64 + ln;
    asm volatile("" : "+v"(t)); return t;
}
__device__ __forceinline__ int bid_l() { int b = blockIdx.x; asm volatile("" : "+s"(b)); return b; }
namespace pg8 {
#define PG8_LAS __attribute__((address_space(3)))
typedef unsigned short bf16_t;
typedef short bf16x8 __attribute__((ext_vector_type(8)));
typedef float f32x4 __attribute__((ext_vector_type(4)));
typedef unsigned u32x4 __attribute__((ext_vector_type(4)));
typedef unsigned u32x2 __attribute__((ext_vector_type(2)));
constexpr int BM = 256, BK = 64, HALF = 128, HTB = HALF * BK * 2  , STAGE_BYTES = 8 * HTB, NXCD = 8, WGM = 8;

__host__ __device__ __forceinline__ int lds_byte(int r, int c) { const int st = (r >> 4) * 2 + (c >> 5), rr = r & 15, cc = c & 31, ob = rr * 64 + cc * 2; return st * 1024 + (ob ^ (((ob >> 9) & 1) << 5)); }
__host__ __device__ __forceinline__ void stage_rc(int b, int& R, int& C) { const int st = b / 1024, sb = b % 1024, swz = sb ^ (((sb >> 9) & 1) << 5); R = (st >> 1) * 16 + swz / 64; C = (st & 1) * 32 + (swz % 64) / 2; }
__host__ __device__ __forceinline__ int perm32(int rho) { const int n = rho >> 4, i = rho & 15; return 8 * (i >> 2) + 4 * n + (i & 3); }

struct Unit { int pm, pn, e, rows, mt; };
struct Gemm { const bf16_t* A; const bf16_t* Bt; int M, N, K; };

struct StaticOrder {
    int nM, nN, nwg, G, c;
    __host__ __device__ void init(int M, int N, int G_, int c_) { nM = M / BM; nN = N / BM; nwg = nM * nN; G = G_; c = c_; }
    __host__ __device__ bool next(int i, Unit& u) const {
        const long L = (long)i * G + c; if (L >= nwg) return false;
        int wgid = (int)L; { const int q = nwg / NXCD, r = nwg % NXCD, xcd = wgid % NXCD, off = wgid / NXCD; wgid = (xcd < r ? xcd * (q + 1) : r * (q + 1) + (xcd - r) * q) + off; }
        const int nig = WGM * nN, gid = wgid / nig, fm = gid * WGM, gsz = (nM - fm) < WGM ? (nM - fm) : WGM;
        u.pm = fm + ((wgid % nig) % gsz); u.pn = (wgid % nig) / gsz; u.e = 0; u.rows = 256; u.mt = 0; return true;
    }
    __device__ __forceinline__ const char* b_base(const Gemm& g, const Unit& u, size_t tstep) const { return (const char*)g.Bt + (size_t)u.pn * tstep; }
    __device__ __forceinline__ int arow(const Unit& u, int r) const { return u.pm * BM + r; }
};

__device__ __forceinline__ unsigned cvt_pk_bf16(float lo, float hi) { unsigned r; asm volatile("v_cvt_pk_bf16_f32 %0, %1, %2" : "=v"(r) : "v"(lo), "v"(hi)); return r; }

struct NoPre { __device__ __forceinline__ void operator()() const {} };
template <class Epi, class Sched, bool GATHER = false, class Pre = NoPre>
__device__ __forceinline__ void gemm_phase(PG8_LAS unsigned char* lds, const Gemm g, const Sched& S, const Epi& E, const Pre& pre = Pre()) {
    const int tid = tid_l(), wid = __builtin_amdgcn_readfirstlane(tid >> 6), lane = tid & 63, wr = wid >> 2, wc = wid & 3, fr = lane & 15, fq = lane >> 4;
    const int K = g.K, nt = K / BK;
    unsigned voffA[2], voffB[2]; int stR[2], stC[2];
#pragma unroll
    for (int i = 0; i < 2; ++i) { int R, C; stage_rc(tid * 16 + i * 8192, R, C); const int Rb = Epi::PERM ? ((R & ~31) + perm32(R & 31)) : R; stR[i] = R; stC[i] = C;
        voffA[i] = (unsigned)(R * K + C) * 2u; voffB[i] = (unsigned)(Rb * K + C) * 2u; }
    const size_t kstep = (size_t)(BK * 2);
    const size_t hstep = (size_t)HALF * K * 2;
    const size_t tstep = 2 * hstep;
    const unsigned ldsw = (unsigned)wid * 1024u;
    const int aoff = lds_byte(wr * 64 + fr, fq * 8), boff = lds_byte(wc * 32 + fr, fq * 8);
#define PG8_SA(b, h) (((b) * 2 + (h)) * HTB)
#define PG8_SB(b, h) ((4 + (b) * 2 + (h)) * HTB)
#define PG8_STAGE(bufoff, gbase, voff) do { _Pragma("unroll") for (int _i = 0; _i < 2; ++_i) \
        __builtin_amdgcn_global_load_lds((const unsigned*)((const char*)(gbase) + (voff)[_i]), (PG8_LAS unsigned*)(lds + (bufoff) + ldsw + _i * 8192), 16, 0, 0); } while (0)
#define PG8_STAGE_A(bufoff, p, kb, h, nx) do { if constexpr (GATHER) { unsigned _vo[2]; _vo[0] = (nx) ? goN[h][0] : goC[h][0]; _vo[1] = (nx) ? goN[h][1] : goC[h][1]; PG8_STAGE(bufoff, (const char*)g.A + (kb), _vo); } \
        else { PG8_STAGE(bufoff, (p) + (h) * hstep, voffA); } } while (0)
#define PG8_LDA(dst, b, h) do { _Pragma("unroll") for (int m = 0; m < 4; ++m) _Pragma("unroll") for (int k = 0; k < 2; ++k) dst[m][k] = *(const PG8_LAS bf16x8*)(lds + PG8_SA(b, h) + aoff + m * 2048 + k * 1024); } while (0)
#define PG8_LDB(dst, b, h) do { _Pragma("unroll") for (int n = 0; n < 2; ++n) _Pragma("unroll") for (int k = 0; k < 2; ++k) dst[n][k] = *(const PG8_LAS bf16x8*)(lds + PG8_SB(b, h) + boff + n * 2048 + k * 1024); } while (0)
#define PG8_MMA(ai, bj, At, Bt) do { __builtin_amdgcn_s_setprio(1); _Pragma("unroll") for (int m = 0; m < 4; ++m) _Pragma("unroll") for (int n = 0; n < 2; ++n) _Pragma("unroll") for (int k = 0; k < 2; ++k) \
        acc[ai][bj][m][n] = __builtin_amdgcn_mfma_f32_16x16x32_bf16(Bt[n][k], At[m][k], acc[ai][bj][m][n], 0, 0, 0); __builtin_amdgcn_s_setprio(0); } while (0)
#define PG8_WAIT_V(n) asm volatile("s_waitcnt vmcnt(" #n ")" ::: "memory")
#define PG8_WAIT_L(n) asm volatile("s_waitcnt lgkmcnt(" #n ")" ::: "memory")
#define PG8_BAR __builtin_amdgcn_s_barrier()
#define PG8_SCHED __builtin_amdgcn_sched_barrier(0)
    Unit cur, nxt; int ui = 0;
    if (!S.next(0, cur)) return;
    f32x4 acc[2][2][4][2];
#pragma unroll
    for (int a = 0; a < 2; ++a)
#pragma unroll
        for (int b = 0; b < 2; ++b)
#pragma unroll
            for (int m = 0; m < 4; ++m)
#pragma unroll
                for (int n = 0; n < 2; ++n) acc[a][b][m][n] = (f32x4){0.f, 0.f, 0.f, 0.f};
    bf16x8 At[4][2], B0[2][2], B1[2][2];
    unsigned goC[2][2], goN[2][2];
    if constexpr (GATHER) {
#pragma unroll
        for (int h = 0; h < 2; ++h)
#pragma unroll
            for (int i = 0; i < 2; ++i) { goC[h][i] = ((unsigned)S.arow(cur, h * HALF + stR[i]) * (unsigned)K + (unsigned)stC[i]) * 2u; goN[h][i] = goC[h][i]; }
    }
    const char* cA = (const char*)g.A + (size_t)cur.pm * tstep; const char* cB = S.b_base(g, cur, tstep);
    PG8_STAGE(PG8_SB(0, 0), cB, voffB); PG8_STAGE(PG8_SB(0, 1), cB + hstep, voffB); pre(); PG8_STAGE_A(PG8_SA(0, 0), cA, 0, 0, false); PG8_STAGE_A(PG8_SA(0, 1), cA, 0, 1, false);
    if (wr == 1) PG8_BAR;
    PG8_WAIT_V(2); PG8_BAR;
    PG8_STAGE(PG8_SB(1, 0), cB + kstep, voffB); PG8_STAGE_A(PG8_SA(1, 0), cA + kstep, kstep, 0, false); PG8_STAGE(PG8_SB(1, 1), cB + hstep + kstep, voffB);
    PG8_WAIT_V(6); PG8_BAR;
    for (;;) {
        const bool has_next = S.next(ui + 1, nxt);
        const char* nA = has_next ? (const char*)g.A + (size_t)nxt.pm * tstep : cA; const char* nB = has_next ? S.b_base(g, nxt, tstep) : cB;
        if constexpr (GATHER) {
#pragma unroll
            for (int h = 0; h < 2; ++h)
#pragma unroll
                for (int i = 0; i < 2; ++i) goN[h][i] = has_next ? ((unsigned)S.arow(nxt, h * HALF + stR[i]) * (unsigned)K + (unsigned)stC[i]) * 2u : goC[h][i];
        }
_Pragma("nounroll")
        for (int t = 0; t < nt; t += 2) {
            if constexpr (Epi::HAS_MID) { if (t == nt / 2) {
#pragma unroll
                for (int a = 0; a < 2; ++a)
#pragma unroll
                    for (int mp = 0; mp < 2; ++mp) { f32x4 f8[2][2][2]; E.mid8(cur, wr, wc, fr, fq, a, mp, f8);
#pragma unroll
                        for (int mm = 0; mm < 2; ++mm)
#pragma unroll
                            for (int b = 0; b < 2; ++b)
#pragma unroll
                                for (int n = 0; n < 2; ++n) acc[a][b][2 * mp + mm][n] = acc[a][b][2 * mp + mm][n] * f8[mm][b][n];
                        asm volatile("" ::: "memory"); } } }
            const bool last = (t == nt - 2);
            const char* a1 = cA + (size_t)(t + 1) * kstep; const size_t k1 = (size_t)(t + 1) * kstep;
            const char* a2 = last ? nA : cA + (size_t)(t + 2) * kstep; const char* b2 = last ? nB : cB + (size_t)(t + 2) * kstep; const size_t k2 = last ? 0 : (size_t)(t + 2) * kstep;
            const char* a3 = a2 + kstep; const char* b3 = b2 + kstep; const size_t k3 = k2 + kstep;
            PG8_LDB(B0, 0, 0); PG8_LDB(B1, 0, 1); PG8_SCHED; PG8_LDA(At, 0, 0); PG8_STAGE_A(PG8_SA(1, 1), a1, k1, 1, false);
            PG8_WAIT_V(8); PG8_WAIT_L(0); PG8_BAR; PG8_MMA(0, 0, At, B0); PG8_MMA(0, 1, At, B1); PG8_BAR; PG8_SCHED;
            PG8_LDA(At, 0, 1); PG8_STAGE(PG8_SB(0, 0), b2, voffB); PG8_STAGE(PG8_SB(0, 1), b2 + hstep, voffB); PG8_STAGE_A(PG8_SA(0, 0), a2, k2, 0, last);
            PG8_WAIT_V(8); PG8_WAIT_L(0); PG8_BAR; PG8_MMA(1, 0, At, B0); PG8_MMA(1, 1, At, B1); PG8_BAR; PG8_SCHED;
            PG8_LDB(B0, 1, 0); PG8_LDB(B1, 1, 1); PG8_SCHED; PG8_LDA(At, 1, 0); PG8_STAGE_A(PG8_SA(0, 1), a2, k2, 1, last);
            PG8_WAIT_V(8); PG8_WAIT_L(0); PG8_BAR; PG8_MMA(0, 0, At, B0); PG8_MMA(0, 1, At, B1); PG8_BAR; PG8_SCHED;
            PG8_LDA(At, 1, 1); PG8_STAGE(PG8_SB(1, 0), b3, voffB); PG8_STAGE(PG8_SB(1, 1), b3 + hstep, voffB); PG8_STAGE_A(PG8_SA(1, 0), a3, k3, 0, last);
            PG8_WAIT_V(8); PG8_WAIT_L(0); PG8_BAR; PG8_MMA(1, 0, At, B0); PG8_MMA(1, 1, At, B1); PG8_BAR; PG8_SCHED;
        }
        if (wr == 0) PG8_BAR;
        E(acc, cur, wr, wc, fr, fq);
        if (!has_next) break;
#pragma unroll
        for (int a = 0; a < 2; ++a)
#pragma unroll
            for (int b = 0; b < 2; ++b)
#pragma unroll
                for (int m = 0; m < 4; ++m)
#pragma unroll
                    for (int n = 0; n < 2; ++n) acc[a][b][m][n] = (f32x4){0.f, 0.f, 0.f, 0.f};
        cur = nxt; cA = nA; cB = nB; ++ui;
        if constexpr (GATHER) {
#pragma unroll
            for (int h = 0; h < 2; ++h)
#pragma unroll
                for (int i = 0; i < 2; ++i) goC[h][i] = goN[h][i];
        }
        if (wr == 1) PG8_BAR;
    }
    PG8_WAIT_V(0);
    PG8_BAR;
#undef PG8_SA
#undef PG8_SB
#undef PG8_STAGE
#undef PG8_STAGE_A
#undef PG8_LDA
#undef PG8_LDB
#undef PG8_MMA
#undef PG8_WAIT_V
#undef PG8_WAIT_L
#undef PG8_BAR
#undef PG8_SCHED
}
}

constexpr int NWAVES = 8, NT = NWAVES * 64;
constexpr int D = 1024, BATCH = 4, SEQ = 4096, M = BATCH * SEQ, DEPTH = 4;
constexpr int CW = 512;
constexpr int ZW = 5120;
constexpr int INW = 5144;
constexpr int ZC_R = 0, ZC_K = 512, ZC_V = 1024, ZC_WL = 1536, ZC_AL = 1600, ZC_GL = 1664, ZC_Q = 1792, ZC_KC = 2304, ZC_VC = 2432, ZC_KS = 2560, ZC_VS = 2688, ZC_KW = 2816, ZC_VW = 2944, ZC_GRW = 3072, ZC_GNSA = 4096;
constexpr int NEXP = 32, DEXP = 512;
constexpr int LOR_PN = ZC_WL / 256;
static_assert(ZC_WL % 256 == 0 && ZC_Q == ZC_WL + 256, "LoRA inputs fill one column tile");
constexpr int CMP_PN = ZC_KC / 256;
static_assert(ZC_KC % 256 == 0 && ZC_VC == ZC_KC + 128, "compression inputs fill one column tile");
constexpr float LN_EPS = 1e-5f, GN_EPS = 64e-5f;
constexpr float ALPHA = 1.6817928305074290f;
constexpr int NCMP = 255;

constexpr size_t MiB = 1u << 20;
constexpr size_t WS_CTL = 0, CTL_ZERO_BYTES = 1 * MiB;
constexpr size_t WS_WIN = 2 * MiB, WS_WLORA = 12 * MiB, WS_WUPR = 13 * MiB, WS_WUPN = 14 * MiB, WS_WOUT = 15 * MiB;
constexpr size_t WS_WC1K = 17 * MiB, WS_WC1V = 17 * MiB + 512 * 1024, WS_WC2K = 18 * MiB, WS_WC2V = 18 * MiB + 64 * 1024, WS_PEB = 18 * MiB + 128 * 1024, WS_LUT = 18 * MiB + 192 * 1024;
constexpr size_t WS_WGT = 18 * MiB + 256 * 1024, WS_WRH = 18 * MiB + 512 * 1024, WS_WRL = 18 * MiB + 896 * 1024;
constexpr size_t WS_W13 = 20 * MiB, WS_W2 = 84 * MiB, WS_W2B = 604 * MiB;
__device__ __forceinline__ size_t ws_w2(int l) { return (l & 1) ? WS_W2B : WS_W2; }
constexpr size_t WS_Z = 116 * MiB;
constexpr size_t WS_S = 276 * MiB;
constexpr size_t WS_Y = 500 * MiB, WS_AP = 532 * MiB, WS_YRW = 540 * MiB, WS_YNSA = 556 * MiB, WS_MERGED = 572 * MiB;
constexpr size_t WS_X1 = 604 * MiB, WS_XB = 668 * MiB, WS_X2 = 700 * MiB, WS_CMP = 700 * MiB, WS_LOR = 636 * MiB, WS_YS = 708 * MiB,     WS_VST = 764 * MiB, WS_VWT = 768 * MiB, WS_KC = 772 * MiB, WS_VCT = 772 * MiB + 256 * 1024;
constexpr size_t WS_GATES = 773 * MiB, WS_LISTS = 775 * MiB, WS_SLOTW = 777 * MiB, WS_CHK = 780 * MiB, WS_OACC = 872 * MiB, WS_END = 888 * MiB;
constexpr size_t SARR = (size_t)M * CW * 4;
constexpr int CW_TMO = 0;
constexpr int CW_BAR = 4096;
constexpr int CW_Q = 24576;
constexpr int CW_CV = 28672;
constexpr int CW_PANEL = 65536;
constexpr int CW_CNT = 16384;
constexpr int RING_BYTES = 131072;
constexpr int XBASE = 135168;
constexpr int MISC_OFF = XBASE + 320;
constexpr int LDS_BYTES = 147456;

#define GAS __attribute__((address_space(1)))
#define LAS __attribute__((address_space(3)))
#define GAS __attribute__((address_space(1)))
typedef unsigned short bf16;
typedef unsigned v4u __attribute__((ext_vector_type(4)));
typedef unsigned v2u __attribute__((ext_vector_type(2)));
typedef float f32x4 __attribute__((ext_vector_type(4)));
typedef float f32x16 __attribute__((ext_vector_type(16)));
typedef short bf16x8 __attribute__((ext_vector_type(8)));
typedef short s16x4 __attribute__((ext_vector_type(4)));
typedef GAS unsigned gu32;
#define RLX_AGENT __ATOMIC_RELAXED, __HIP_MEMORY_SCOPE_AGENT
#define LDS_WAIT() asm volatile("s_waitcnt lgkmcnt(0)" ::: "memory")
#define VM_WAIT() asm volatile("s_waitcnt vmcnt(0)" ::: "memory")
typedef float f32x2_t __attribute__((ext_vector_type(2)));
typedef __bf16 bf16x2_t __attribute__((ext_vector_type(2)));
__device__ __forceinline__ unsigned cvtpk(float lo, float hi) { const f32x2_t v = {lo, hi}; const bf16x2_t b = __builtin_convertvector(v, bf16x2_t); return __builtin_bit_cast(unsigned, b); }
__device__ __forceinline__ unsigned pk2(float lo, float hi) { return cvtpk(lo, hi); }
__device__ __forceinline__ void st_wt(void* p, v4u v) { asm volatile("global_store_dwordx4 %0, %1, off sc1\n\ts_nop 1" :: "v"((GAS void*)p), "v"(v) : "memory"); }
__device__ __forceinline__ void st_wt_nb(void* p, v4u v) { asm volatile("global_store_dwordx4 %0, %1, off sc1\n\ts_nop 1" :: "v"((GAS void*)p), "v"(v)); }

__device__ __forceinline__ unsigned f2bf(float f) { return cvtpk(f, 0.f) & 0xffffu; }
__device__ __forceinline__ float bf2f(unsigned short b) { return __builtin_bit_cast(float, ((unsigned)b) << 16); }
__device__ __forceinline__ float bflo(unsigned w) { return __builtin_bit_cast(float, w << 16); }
__device__ __forceinline__ float bfhi(unsigned w) { return __builtin_bit_cast(float, w & 0xffff0000u); }
__device__ __forceinline__ float sigmoidf_(float x) { return __builtin_amdgcn_rcpf(1.f + __expf(-x)); }

#define XB_TMO      128
#define XB_XCNT(j)  (256  + 64 * (j))
#define XB_XSUB(j)  (1280 + 64 * (j))
#define XB_XGEN(j)  (2304 + 64 * (j))
#define XB_TOP      3328
#define XB_TOPGEN   3392
#define XCD_BAR_WORDS 3456
#define XB_SPIN_CAP (1u << 18)
__device__ __forceinline__ unsigned xb_ld(unsigned* p)              { return __hip_atomic_load(p, __ATOMIC_RELAXED, __HIP_MEMORY_SCOPE_AGENT); }
__device__ __forceinline__ unsigned xb_add(unsigned* p, unsigned v) { return __hip_atomic_fetch_add(p, v, __ATOMIC_RELAXED, __HIP_MEMORY_SCOPE_AGENT); }
__device__ __forceinline__ unsigned xb_xcc_id() { return (unsigned)__builtin_amdgcn_s_getreg((3 << 11) | 20) & 0xFu; }
#define XB_SPIN(cond, bar) do { unsigned _sp = 0; while (cond) { __builtin_amdgcn_s_sleep(1); \
    if ((++_sp & 255u) == 0u) { if (xb_ld(&(bar)[XB_TMO])) break; if (_sp > XB_SPIN_CAP) { atomicAdd(&(bar)[XB_TMO], 1u); break; } } } } while (0)
struct XcdBarrier { unsigned* bar; unsigned x; volatile LAS unsigned* st; };
__device__ __forceinline__ XcdBarrier xcd_barrier_post(unsigned* bar, volatile LAS unsigned* st) {
    XcdBarrier b; b.bar = bar; b.x = xb_xcc_id(); b.st = st;
    if (threadIdx.x == 0) (void)xb_add(&bar[XB_XCNT(b.x)], 1u);
    return b;
}
__device__ __forceinline__ void xcd_barrier_complete(unsigned* bar, unsigned x, unsigned& nloc, unsigned& nx) {
    const unsigned G = gridDim.x * gridDim.y * gridDim.z;
    unsigned sum, cnt, mine, sp = 0u;
    for (;;) {
        sum = 0u; cnt = 0u; mine = 0u;
#pragma unroll
        for (unsigned j = 0; j < 16; ++j) { const unsigned c = xb_ld(&bar[XB_XCNT(j)]); sum += c; cnt += (c > 0u) ? 1u : 0u; mine = (j == x) ? c : mine; }
        if (sum == G) break;
        __builtin_amdgcn_s_sleep(1);
        if ((++sp & 255u) == 0u) { if (xb_ld(&bar[XB_TMO])) break; if (sp > XB_SPIN_CAP) { atomicAdd(&bar[XB_TMO], 1u); break; } }
    }
    nloc = mine > 0u ? mine : 1u; nx = cnt > 0u ? cnt : 1u;
}
__device__ __forceinline__ void xcd_barrier(const XcdBarrier& b) {
    asm volatile("s_waitcnt vmcnt(0)" ::: "memory");
    __syncthreads();
    if (threadIdx.x == 0) {
        unsigned* bar = b.bar;
        __builtin_amdgcn_s_waitcnt(0);
        unsigned nloc = b.st[0], nx = b.st[1];
        if (nloc == 0u) { xcd_barrier_complete(bar, b.x, nloc, nx); b.st[0] = nloc; b.st[1] = nx; }
        const unsigned old = xb_add(&bar[XB_XSUB(b.x)], 1u);
        const unsigned gen = old / nloc;
        if (old + 1u == (gen + 1u) * nloc) {
            __builtin_amdgcn_fence(__ATOMIC_RELEASE, "agent");
            asm volatile("s_waitcnt vmcnt(0)" ::: "memory");
            const unsigned og = xb_add(&bar[XB_TOP], 1u);
            const unsigned tg = og / nx;
            if (og + 1u == (tg + 1u) * nx) xb_add(&bar[XB_TOPGEN], 1u);
            else XB_SPIN(xb_ld(&bar[XB_TOPGEN]) == tg, bar);
            __builtin_amdgcn_fence(__ATOMIC_ACQUIRE, "agent");
            xb_add(&bar[XB_XGEN(b.x)], 1u);
            asm volatile("s_waitcnt vmcnt(0)" ::: "memory");
        } else {
            XB_SPIN(xb_ld(&bar[XB_XGEN(b.x)]) == gen, bar);
            __builtin_amdgcn_fence(__ATOMIC_ACQUIRE, "agent");
            asm volatile("s_waitcnt vmcnt(0)" ::: "memory");
        }
    }
    __syncthreads();
}

struct Frame {
    LAS unsigned char* lds;
    gu32* ctl;
    unsigned char* ws;
    int tid, lane, wave, G, vcu, bid;
};
template<int CTRL> __device__ __forceinline__ float dpp_mov(float v) { return __builtin_bit_cast(float, __builtin_amdgcn_update_dpp(0, __builtin_bit_cast(int, v), CTRL, 0xF, 0xF, true)); }
__device__ __forceinline__ float sum4(float v)  { v += dpp_mov<0xB1>(v); v += dpp_mov<0x4E>(v); return v; }
__device__ __forceinline__ float sum8(float v)  { v = sum4(v); v += dpp_mov<0x141>(v); return v; }
__device__ __forceinline__ float sum16(float v) { v = sum8(v); v += dpp_mov<0x140>(v); return v; }
__device__ __forceinline__ void pl32_swap(unsigned& a, unsigned& b) { asm volatile("s_nop 1\n\tv_permlane32_swap_b32 %0, %1\n\ts_nop 1" : "+v"(a), "+v"(b)); }
__device__ __forceinline__ float x32_sum(float v) { unsigned a = __builtin_bit_cast(unsigned, v), b = a; pl32_swap(a, b); return __builtin_bit_cast(float, a) + __builtin_bit_cast(float, b); }
__device__ __forceinline__ float x32_max(float v) { unsigned a = __builtin_bit_cast(unsigned, v), b = a; pl32_swap(a, b); return fmaxf(__builtin_bit_cast(float, a), __builtin_bit_cast(float, b)); }
__device__ __forceinline__ float wave_sum(float v) {
    v = sum16(v);
    v += __builtin_bit_cast(float, __builtin_amdgcn_update_dpp(0, __builtin_bit_cast(int, v), 0x142, 0xA, 0xF, false));
    v += __builtin_bit_cast(float, __builtin_amdgcn_update_dpp(0, __builtin_bit_cast(int, v), 0x143, 0xC, 0xF, false));
    return __builtin_bit_cast(float, __builtin_amdgcn_readlane(__builtin_bit_cast(int, v), 63));
}

constexpr int TAB_OFF = XBASE + 2048;
__device__ __forceinline__ const float* inp(const Frame& F, int k) {
    const LAS unsigned* t = (const LAS unsigned*)(F.lds + TAB_OFF) + 2 * k;
    const unsigned lo = (unsigned)__builtin_amdgcn_readfirstlane((int)t[0]), hi = (unsigned)__builtin_amdgcn_readfirstlane((int)t[1]);
    return (const float*)(GAS const float*)(((unsigned long long)hi << 32) | lo);
}
__device__ __forceinline__ unsigned char* wsp(const Frame& F) { GAS unsigned char* p = (GAS unsigned char*)F.ws; asm volatile("" : "+s"(p)); return (unsigned char*)p; }
__device__ __forceinline__ f32x4 ld_bf4(const bf16* p) { const v2u w = *(const v2u*)p; return (f32x4){bflo(w.x), bfhi(w.x), bflo(w.y), bfhi(w.y)}; }

struct TrItem { const float* src; bf16* dst; int ld, K; };
__device__ __forceinline__ TrItem tr_mk(const float* W, int ld, int scol0, bf16* WT, int K, int drow0, int k0) { return TrItem{W + (size_t)k0 * ld + scol0, WT + (size_t)drow0 * K + k0, ld, K}; }
__device__ __forceinline__ void tr_load(const TrItem& d, int lane, f32x4 (&w)[8]) {
#pragma unroll
    for (int i = 0; i < 8; ++i) w[i] = *(const f32x4*)(d.src + (size_t)(8 * i + (lane >> 3)) * d.ld + (lane & 7) * 4);
}
__device__ __forceinline__ void tr_store(const TrItem& d, int lane, LAS float* scr, const f32x4 (&w)[8]) {
#pragma unroll
    for (int i = 0; i < 8; ++i) { const int kk = 8 * i + (lane >> 3), c4 = (lane & 7) * 4; scr[kk * 33 + c4] = w[i].x; scr[kk * 33 + c4 + 1] = w[i].y; scr[kk * 33 + c4 + 2] = w[i].z; scr[kk * 33 + c4 + 3] = w[i].w; }
    LDS_WAIT(); asm volatile("" ::: "memory");
    const int c = lane & 7;
#pragma unroll
    for (int j = 0; j < 4; ++j) { const int n = (lane >> 3) + 8 * j; const LAS float* s = scr + (8 * c) * 33 + n;
        v4u o; o.x = pk2(s[0 * 33], s[1 * 33]); o.y = pk2(s[2 * 33], s[3 * 33]); o.z = pk2(s[4 * 33], s[5 * 33]); o.w = pk2(s[6 * 33], s[7 * 33]);
        st_wt(d.dst + (size_t)n * d.K + 8 * c, o); }
    LDS_WAIT(); asm volatile("" ::: "memory");
}
constexpr int CV_I0 = 2560, CV_I1 = 256, CV_I2 = 256, CV_I3 = 512, CV_I4 = 128, CV_I5 = 128, CV_I6 = 4, CV_I7 = 4, CV_I8 = 16384, CV_I9 = 8192;
constexpr int CV_NITEMS = CV_I0 + CV_I1 + CV_I2 + CV_I3 + CV_I4 + CV_I5 + CV_I6 + CV_I7 + CV_I8 + CV_I9;
__device__ __forceinline__ TrItem conv_item(Frame& F, unsigned char* ws, int l, int it) {
    int r = it;
    if (r < CV_I0) { const int kb = r / 160, nb = r % 160, n0 = 32 * nb; return tr_mk(inp(F, 2) + (size_t)l * D * INW, INW, n0 < 3072 ? n0 : n0 + 24, (bf16*)(ws + WS_WIN), D, n0, 64 * kb); } r -= CV_I0;
    if (r < CV_I1) { return tr_mk(inp(F, 20) + (size_t)l * CW * D, D, 32 * (r % 32), (bf16*)(ws + WS_WUPR), D, 32 * (r % 32), 64 * (r / 32)); } r -= CV_I1;
    if (r < CV_I2) { return tr_mk(inp(F, 21) + (size_t)l * CW * D - (size_t)CW * D, D, 32 * (r % 32), (bf16*)(ws + WS_WUPR), D, 32 * (r % 32), 512 + 64 * (r / 32)); } r -= CV_I2;
    if (r < CV_I3) { return tr_mk(inp(F, 22) + (size_t)l * D * D, D, 32 * (r % 32), (bf16*)(ws + WS_WOUT), D, 32 * (r % 32), 64 * (r / 32)); } r -= CV_I3;
    if (r < CV_I4) { return tr_mk(inp(F, 15) + (size_t)l * 2048 * 128, 128, 32 * (r % 4), (bf16*)(ws + WS_WC1K), 2048, 32 * (r % 4), 64 * (r / 4)); } r -= CV_I4;
    if (r < CV_I5) { return tr_mk(inp(F, 18) + (size_t)l * 2048 * 128, 128, 32 * (r % 4), (bf16*)(ws + WS_WC1V), 2048, 32 * (r % 4), 64 * (r / 4)); } r -= CV_I5;
    if (r < CV_I6) { return tr_mk(inp(F, 16) + (size_t)l * 128 * 64, 64, 32 * (r % 2), (bf16*)(ws + WS_WC2K), 128, 32 * (r % 2), 64 * (r / 2)); } r -= CV_I6;
    if (r < CV_I7) { return tr_mk(inp(F, 19) + (size_t)l * 128 * 64, 64, 32 * (r % 2), (bf16*)(ws + WS_WC2V), 128, 32 * (r % 2), 64 * (r / 2)); } r -= CV_I7;
    if (r < CV_I8) { const int e = r / 512, rr = r % 512, mat = rr / 256, q = rr % 256, kb = q / 16, nb = q % 16, pn = nb / 4, cc0 = (nb % 4) * 32;
        return tr_mk(inp(F, mat ? 30 : 29) + ((size_t)l * NEXP + e) * D * DEXP, DEXP, 32 * nb, (bf16*)(ws + WS_W13) + (size_t)e * 1024 * 1024, D, 256 * pn + 128 * mat + cc0, 64 * kb); } r -= CV_I8;
    { const int e = r / 256, q = r % 256, kb = q / 32, nb = q % 32;
        return tr_mk(inp(F, 31) + ((size_t)l * NEXP + e) * DEXP * D, D, 32 * nb, (bf16*)(ws + ws_w2(l)) + (size_t)e * 1024 * 512, DEXP, 32 * nb, 64 * kb); }
}
constexpr int CV_CAT0 = CV_I0 + CV_I1 + CV_I2 + CV_I3 + CV_I4 + CV_I5 + CV_I6 + CV_I7, CV_CAT1 = CV_I8, CV_CAT2 = CV_I9;
static_assert(CV_CAT0 % 8 == 0 && CV_CAT1 % 8 == 0 && CV_CAT2 % 8 == 0, "fill granularity");
__device__ __forceinline__ void conv_fill8(Frame& F, int l, int i0) {
    LAS float* scr = (LAS float*)(F.lds + F.wave * 16384);
    unsigned char* ws = wsp(F); const int lane = F.lane;
    TrItem d0, d1, d2; f32x4 w0[8], w1[8], w2[8];
    d0 = conv_item(F, ws, l, i0); tr_load(d0, lane, w0); d1 = conv_item(F, ws, l, i0 + 1); tr_load(d1, lane, w1);
    d2 = conv_item(F, ws, l, i0 + 2); tr_load(d2, lane, w2); tr_store(d0, lane, scr, w0);
    d0 = conv_item(F, ws, l, i0 + 3); tr_load(d0, lane, w0); tr_store(d1, lane, scr, w1);
    d1 = conv_item(F, ws, l, i0 + 4); tr_load(d1, lane, w1); tr_store(d2, lane, scr, w2);
    d2 = conv_item(F, ws, l, i0 + 5); tr_load(d2, lane, w2); tr_store(d0, lane, scr, w0);
    d0 = conv_item(F, ws, l, i0 + 6); tr_load(d0, lane, w0); tr_store(d1, lane, scr, w1);
    d1 = conv_item(F, ws, l, i0 + 7); tr_load(d1, lane, w1); tr_store(d2, lane, scr, w2);
    tr_store(d0, lane, scr, w0); tr_store(d1, lane, scr, w1);
}
__device__ __forceinline__ void conv_tail(Frame& F, int l, int total, int ph) {
    const int rem = (total * 4) & 255;
    if (rem != 0 && F.vcu >= rem) { const int first = ((F.vcu - rem) * 8 + F.wave) * 8;
        if (ph == 0) { if (first < CV_CAT0) conv_fill8(F, l, first); else if (first < CV_CAT0 + CV_CAT2) conv_fill8(F, l, first + CV_CAT1); }
        else if (first < CV_CAT1) conv_fill8(F, l, CV_CAT0 + first); }
}
template <int MODE> __device__ __forceinline__ void conv_phase(Frame& F, int l, int total) {
    LAS float* scr = (LAS float*)(F.lds + F.wave * 16384);
    unsigned char* ws = wsp(F);
    const int gw = (MODE >= 2 ? (F.bid - 32) : F.vcu) * NWAVES + F.wave, NGW = (MODE >= 2 ? 32 : 256) * NWAVES, lane = F.lane;
    int s0 = 0, s1 = 0, s2 = 0;
    if (MODE == 1) { s1 = CV_CAT1; s2 = CV_CAT2; }
    if (MODE == 2) s0 = CV_CAT0;
    if (MODE == 0 || MODE == 3) { const int rem = (total * 4) & 255, done = rem ? (256 - rem) * 64 : 0; s0 = done < CV_CAT0 ? done : CV_CAT0; s1 = done < CV_CAT1 ? done : CV_CAT1; s2 = done - s0 < CV_CAT2 ? done - s0 : CV_CAT2; }
    if (MODE == 0) s1 = CV_CAT1;
    if (MODE == 3) { s0 = CV_CAT0; s2 = CV_CAT2; }
    const int n0 = CV_CAT0 - s0, n1 = CV_CAT1 - s1, NLEFT = n0 + n1 + CV_CAT2 - s2;
#define CV_MAP(j) ((j) < n0 ? (j) + s0 : ((j) < n0 + n1 ? (j) - n0 + CV_CAT0 + s1 : (j) - n0 - n1 + CV_CAT0 + CV_CAT1 + s2))
    { TrItem d0, d1, d2; f32x4 w0[8], w1[8], w2[8];
      int it = gw;
      if (it < NLEFT) { d0 = conv_item(F, ws, l, CV_MAP(it)); tr_load(d0, lane, w0); }
      if (it + NGW < NLEFT) { d1 = conv_item(F, ws, l, CV_MAP(it + NGW)); tr_load(d1, lane, w1); }
      for (; it < NLEFT; it += 3 * NGW) {
          const int i1 = it + NGW, i2 = it + 2 * NGW, i3 = it + 3 * NGW, i4 = it + 4 * NGW;
          if (i2 < NLEFT) { d2 = conv_item(F, ws, l, CV_MAP(i2)); tr_load(d2, lane, w2); }
          tr_store(d0, lane, scr, w0);
          if (i1 < NLEFT) { if (i3 < NLEFT) { d0 = conv_item(F, ws, l, CV_MAP(i3)); tr_load(d0, lane, w0); } tr_store(d1, lane, scr, w1);
              if (i2 < NLEFT) { if (i4 < NLEFT) { d1 = conv_item(F, ws, l, CV_MAP(i4)); tr_load(d1, lane, w1); } tr_store(d2, lane, scr, w2); } }
      } }
#undef CV_MAP
}
__device__ __forceinline__ void conv_small(Frame& F, int l) {
    unsigned char* ws = wsp(F); const int lane = F.lane;
    { bf16* WLW = (bf16*)(ws + WS_WLORA); bf16* WLA = WLW + 512 * 64; bf16* WLG = WLA + 512 * 64; const float* w2 = inp(F, 5) + (size_t)l * 64 * CW; const float* a2 = inp(F, 7) + (size_t)l * 64 * CW; const float* g2 = inp(F, 8) + (size_t)l * 128 * CW;
      for (int i = F.vcu * NT + F.tid; i < 512 * 256; i += 256 * NT) { const int c = i >> 8, k = i & 255;
          if (k < 64) WLW[c * 64 + k] = (bf16)f2bf(w2[k * CW + c]); else if (k < 128) WLA[c * 64 + (k - 64)] = (bf16)f2bf(a2[(k - 64) * CW + c]); else WLG[c * 128 + (k - 128)] = (bf16)f2bf(g2[(k - 128) * CW + c]); } }
    if (F.wave == 0) { const int task = F.vcu, which = task >> 7, n = task & 127;
        const float* pe = inp(F, which ? 17 : 14) + (size_t)l * 2048; const float* w1 = inp(F, which ? 18 : 15) + (size_t)l * 2048 * 128; float s = 0.f;
        float pv[32], wv[32];
#pragma unroll
        for (int i = 0; i < 32; ++i) { pv[i] = pe[lane + 64 * i]; wv[i] = w1[(size_t)(lane + 64 * i) * 128 + n]; }
#pragma unroll
        for (int i = 0; i < 32; ++i) s += pv[i] * wv[i];
        s = wave_sum(s); if (lane == 0) ((float*)(ws + WS_PEB))[task] = s; }
}

__device__ __forceinline__ void lut_phase(Frame& F) {
    float* lut = (float*)(wsp(F) + WS_LUT); const float* rb = inp(F, 1);
    for (int i = F.vcu * NT + F.tid; i < 8 * 1024; i += 256 * NT) { const int h = i >> 10, n = i & 1023; int bk = n;
        if (n >= 16) bk = 16 + (n >= 21) + (n >= 27) + (n >= 35) + (n >= 46) + (n >= 59) + (n >= 77) + (n >= 99) + (n >= 128) + (n >= 166) + (n >= 216) + (n >= 280) + (n >= 363) + (n >= 470) + (n >= 609) + (n >= 790);
        lut[i] = rb[bk * 8 + h] * 1.4426950408889634f; }
}
__device__ __forceinline__ void wsmall_phase(Frame& F) {
    unsigned char* ws = wsp(F);
    bf16* wgt = (bf16*)(ws + WS_WGT); bf16* wrh = (bf16*)(ws + WS_WRH); bf16* wrl = (bf16*)(ws + WS_WRL);
    const float* win = inp(F, 2); const float* rg = inp(F, 25); const float* re = inp(F, 27);
    for (int i = F.vcu * NT + F.tid; i < DEPTH * 32 * 1024; i += 256 * NT) { const int ln = i >> 15, n = (i >> 10) & 31, k = i & 1023;
        wgt[i] = (n < 24) ? (bf16)f2bf(win[((size_t)ln * D + k) * INW + 3072 + n]) : (bf16)0; }
    for (int i = F.vcu * NT + F.tid; i < DEPTH * 48 * 1024; i += 256 * NT) { const int ln = i / (48 * 1024), n = (i >> 10) % 48, k = i & 1023;
        float v = 0.f; if (n < 4) v = rg[((size_t)ln * D + k) * 4 + n]; else if (n < 36) v = re[((size_t)ln * D + k) * 32 + (n - 4)];
        const unsigned h = f2bf(v); wrh[i] = (bf16)h; wrl[i] = (bf16)f2bf(v - bf2f((bf16)h)); }
}
constexpr int LN_PITCH = 1032, LN_XH = 0, LN_XL = 16 * LN_PITCH * 2, LN_PART = 2 * 16 * LN_PITCH * 2, LN_LGA = LN_PART + 8 * 16 * 48 * 4;
__device__ __forceinline__ int ln_col(int lane, int j) { return 8 * lane + 512 * (j >> 1) + 4 * (j & 1); }
template <int MODE> __device__ __forceinline__ void ln_rows_load(Frame& F, unsigned char* ws, int m, int lane, f32x4 (&a)[4], v2u (&y0)[4], v2u (&y1)[4], v2u (&yx)[4]) {
    if (MODE == 0) {
#pragma unroll
        for (int j = 0; j < 4; ++j) a[j] = *(const f32x4*)(inp(F, 0) + (size_t)m * D + ln_col(lane, j));
    } else {
#pragma unroll
        for (int jj = 0; jj < 2; ++jj) { const size_t o = (size_t)m * D + 8 * lane + 512 * jj;
            if (MODE == 1) { const v4u t = *(const v4u*)((const bf16*)(ws + WS_S + 64 * MiB) + o); yx[2 * jj] = (v2u){t.x, t.y}; yx[2 * jj + 1] = (v2u){t.z, t.w}; }
            else { const v4u t = *(const v4u*)((const bf16*)(ws + WS_XB) + o), p = *(const v4u*)((const bf16*)(ws + WS_YS) + o), q = *(const v4u*)((const bf16*)(ws + WS_YS) + (size_t)M * D + o);
                yx[2 * jj] = (v2u){t.x, t.y}; yx[2 * jj + 1] = (v2u){t.z, t.w}; y0[2 * jj] = (v2u){p.x, p.y}; y0[2 * jj + 1] = (v2u){p.z, p.w}; y1[2 * jj] = (v2u){q.x, q.y}; y1[2 * jj + 1] = (v2u){q.z, q.w}; } }
    }
}
template <int MODE> __device__ __forceinline__ void ln_phase(Frame& F, int l, float* outp) {
    unsigned char* ws = wsp(F); const int lane = F.lane, w = F.wave, tid = F.tid;
    LAS bf16* xh = (LAS bf16*)(F.lds + LN_XH); LAS bf16* xl = (LAS bf16*)(F.lds + LN_XL); LAS float* part = (LAS float*)(F.lds + LN_PART); LAS float* lga = (LAS float*)(F.lds + LN_LGA);
    const int lnext = (MODE == 0) ? 0 : l + 1; const bool proj = (MODE == 1) || (lnext < DEPTH);
    constexpr int NTL = (MODE == 1) ? 3 : 2;
    f32x4 ra[2][2][4]; v2u ry0[2][2][4], ry1[2][2][4], ryx[2][2][4];
#pragma unroll
    for (int rr = 0; rr < 2; ++rr) ln_rows_load<MODE>(F, ws, F.bid * 64 + 2 * w + rr, lane, ra[0][rr], ry0[0][rr], ry1[0][rr], ryx[0][rr]);
    __builtin_amdgcn_sched_barrier(0);
    f32x4 g4[4], b4[4];
    if (MODE != 0) { const float* gp = inp(F, MODE == 1 ? 23 : 32) + (size_t)l * D; const float* bp = inp(F, MODE == 1 ? 24 : 33) + (size_t)l * D;
#pragma unroll
        for (int j = 0; j < 4; ++j) { g4[j] = *(const f32x4*)(gp + ln_col(lane, j)); b4[j] = *(const f32x4*)(bp + ln_col(lane, j)); } }
    bf16x8 wb1[4][NTL], wb2[4][NTL];
    if (proj) { const int fr = lane & 15, fq = lane >> 4;
        const bf16* bh = (MODE == 1) ? (const bf16*)(ws + WS_WRH) + ((size_t)l * 48 + fr) * 1024 + 8 * fq + 128 * w : (const bf16*)(ws + WS_WGT) + ((size_t)lnext * 32 + fr) * 1024 + 8 * fq + 128 * w;
        const bf16* bl = (const bf16*)(ws + WS_WRL) + ((size_t)l * 48 + fr) * 1024 + 8 * fq + 128 * w;
#pragma unroll
        for (int k4 = 0; k4 < 4; ++k4)
#pragma unroll
            for (int nt = 0; nt < NTL; ++nt) {
                if (MODE == 0) {
                    const int n = 16 * nt + fr; const float* wp = inp(F, 2) + (size_t)(128 * w + 32 * k4 + 8 * fq) * INW + 3072 + (n < 24 ? n : 0); float f[8];
#pragma unroll
                    for (int j = 0; j < 8; ++j) { const float t = wp[(size_t)j * INW]; f[j] = n < 24 ? t : 0.f; }
                    const v4u pk = (v4u){cvtpk(f[0], f[1]), cvtpk(f[2], f[3]), cvtpk(f[4], f[5]), cvtpk(f[6], f[7])}; wb1[k4][nt] = __builtin_bit_cast(bf16x8, pk);
                } else { wb1[k4][nt] = *(const bf16x8*)(bh + (size_t)nt * 16 * 1024 + 32 * k4); if (MODE == 1) wb2[k4][nt] = *(const bf16x8*)(bl + (size_t)nt * 16 * 1024 + 32 * k4); } } }
#pragma unroll
    for (int bt = 0; bt < 4; ++bt) {
        const int m0 = F.bid * 64 + bt * 16;
        if (bt + 1 < 4) {
#pragma unroll
            for (int rr = 0; rr < 2; ++rr) ln_rows_load<MODE>(F, ws, m0 + 16 + 2 * w + rr, lane, ra[(bt + 1) & 1][rr], ry0[(bt + 1) & 1][rr], ry1[(bt + 1) & 1][rr], ryx[(bt + 1) & 1][rr]);
        }
        __syncthreads();
#pragma unroll
        for (int rr = 0; rr < 2; ++rr) {
            const int row = 2 * w + rr, m = m0 + row;
            f32x4 v[4];
#pragma unroll
            for (int j = 0; j < 4; ++j) { if (MODE == 0) v[j] = ra[bt & 1][rr][j];
                if (MODE == 1) { const v2u x = ryx[bt & 1][rr][j]; v[j] = (f32x4){bflo(x.x), bfhi(x.x), bflo(x.y), bfhi(x.y)}; }
                if (MODE == 2) { const v2u p = ry0[bt & 1][rr][j], q = ry1[bt & 1][rr][j], x = ryx[bt & 1][rr][j];
                    v[j] = (f32x4){bflo(x.x), bfhi(x.x), bflo(x.y), bfhi(x.y)} * ALPHA + ((f32x4){bflo(p.x), bfhi(p.x), bflo(p.y), bfhi(p.y)} + (f32x4){bflo(q.x), bfhi(q.x), bflo(q.y), bfhi(q.y)}); } }
            if (MODE != 0) {
                float s = 0.f;
#pragma unroll
                for (int j = 0; j < 4; ++j) s += (v[j].x + v[j].y) + (v[j].z + v[j].w);
                const float mean = wave_sum(s) * (1.f / D); float s2 = 0.f;
#pragma unroll
                for (int j = 0; j < 4; ++j) { v[j] = v[j] - mean; s2 += (v[j].x * v[j].x + v[j].y * v[j].y) + (v[j].z * v[j].z + v[j].w * v[j].w); }
                const float rstd = 1.f / sqrtf(wave_sum(s2) * (1.f / D) + LN_EPS);
#pragma unroll
                for (int j = 0; j < 4; ++j) v[j] = v[j] * rstd * g4[j] + b4[j];
                if (MODE == 2 && outp) {
#pragma unroll
                    for (int j = 0; j < 4; ++j) *(f32x4*)(outp + (size_t)m * D + ln_col(lane, j)) = v[j]; }
            }
            bf16* xb = (bf16*)(ws + WS_XB);
#pragma unroll
            for (int jj = 0; jj < 2; ++jj) { const f32x4 va = v[2 * jj], vb = v[2 * jj + 1];
                const v4u o = (v4u){pk2(va.x, va.y), pk2(va.z, va.w), pk2(vb.x, vb.y), pk2(vb.z, vb.w)};
                if (!(MODE == 2 && outp)) st_wt_nb(xb + (size_t)m * D + 8 * lane + 512 * jj, o);
                if (proj) { *(LAS v4u*)(xh + row * LN_PITCH + 8 * lane + 512 * jj) = o;
                    if (MODE == 1) { const v4u q = (v4u){pk2(va.x - bflo(o.x), va.y - bfhi(o.x)), pk2(va.z - bflo(o.y), va.w - bfhi(o.y)), pk2(vb.x - bflo(o.z), vb.y - bfhi(o.z)), pk2(vb.z - bflo(o.w), vb.w - bfhi(o.w))};
                        *(LAS v4u*)(xl + row * LN_PITCH + 8 * lane + 512 * jj) = q; } } }
        }
        if (!proj) continue;
        __syncthreads();
        {
            const int fr = lane & 15, fq = lane >> 4;
            pg8::f32x4 acc[NTL];
#pragma unroll
            for (int nt = 0; nt < NTL; ++nt) acc[nt] = (pg8::f32x4){0.f, 0.f, 0.f, 0.f};
            __builtin_amdgcn_sched_barrier(0);
#pragma unroll
            for (int k4 = 0; k4 < 4; ++k4) {
                const bf16x8 ah = *(const LAS bf16x8*)(xh + fr * LN_PITCH + 128 * w + 32 * k4 + 8 * fq);
                bf16x8 al; if (MODE == 1) al = *(const LAS bf16x8*)(xl + fr * LN_PITCH + 128 * w + 32 * k4 + 8 * fq);
#pragma unroll
                for (int nt = 0; nt < NTL; ++nt) {
                    acc[nt] = __builtin_amdgcn_mfma_f32_16x16x32_bf16(ah, wb1[k4][nt], acc[nt], 0, 0, 0);
                    if (MODE == 1) { acc[nt] = __builtin_amdgcn_mfma_f32_16x16x32_bf16(ah, wb2[k4][nt], acc[nt], 0, 0, 0);
                        acc[nt] = __builtin_amdgcn_mfma_f32_16x16x32_bf16(al, wb1[k4][nt], acc[nt], 0, 0, 0); } } }
#pragma unroll
            for (int nt = 0; nt < NTL; ++nt)
#pragma unroll
                for (int r = 0; r < 4; ++r) part[(w * 16 + 4 * fq + r) * 48 + 16 * nt + fr] = acc[nt][r];
        }
        __syncthreads();
        for (int i = tid; i < 16 * 16 * NTL; i += NT) { const int row = i / (16 * NTL), n = i % (16 * NTL); float s = 0.f;
#pragma unroll
            for (int w8 = 0; w8 < 8; ++w8) s += part[(w8 * 16 + row) * 48 + n];
            lga[(bt * 16 + row) * 48 + n] = s; }
    }
    __syncthreads();
    if (proj) {
        if (MODE != 1) {
            for (int i = tid; i < 64 * 24; i += NT) { const int tk = i / 24, n = i % 24; ((float*)(ws + WS_GATES))[(size_t)(F.bid * 64 + tk) * 24 + n] = lga[tk * 48 + n]; }
        } else if (tid < 64) {
            const LAS float* q = lga + tid * 48; const int m = F.bid * 64 + tid;
            const float* bg = inp(F, 26) + l * 4; const float* be = inp(F, 28) + l * 32;
            int grp = 0; float gm = q[0] + bg[0];
#pragma unroll
            for (int n = 1; n < 4; ++n) { const float a = q[n] + bg[n]; if (a > gm) { gm = a; grp = n; } }
            float gs = 0.f;
#pragma unroll
            for (int n = 0; n < 4; ++n) gs += __expf(q[n] + bg[n] - gm);
            const float pgrp = 1.f / gs;
            int i0 = 0, i1 = -1; float v0 = -3.0e38f, v1 = -3.0e38f;
            float ev[8];
#pragma unroll
            for (int i = 0; i < 8; ++i) ev[i] = q[4 + grp * 8 + i] + be[grp * 8 + i];
#pragma unroll
            for (int i = 0; i < 8; ++i) { const float a = ev[i]; if (a > v0) { v1 = v0; i1 = i0; v0 = a; i0 = i; } else if (a > v1) { v1 = a; i1 = i; } }
            const float w0 = 1.f / (1.f + __expf(v1 - v0)), w1 = 1.f - w0;
            const int e0 = grp * 8 + i0, e1 = grp * 8 + i1;
            LAS unsigned* lc = (LAS unsigned*)(F.lds + LN_LGA + 64 * 48 * 4);
            lc[tid] = 0u;
            asm volatile("s_waitcnt lgkmcnt(0)" ::: "memory");
            const unsigned r0 = __hip_atomic_fetch_add(lc + e0, 1u, __ATOMIC_RELAXED, __HIP_MEMORY_SCOPE_WORKGROUP);
            const unsigned r1 = __hip_atomic_fetch_add(lc + e1, 1u, __ATOMIC_RELAXED, __HIP_MEMORY_SCOPE_WORKGROUP);
            asm volatile("s_waitcnt lgkmcnt(0)" ::: "memory");
            if (tid < 32) { const unsigned c = lc[tid]; unsigned bs = 0u; if (c) bs = __hip_atomic_fetch_add((unsigned*)(F.ctl + CW_CNT + (l * 32 + tid) * 64), c, RLX_AGENT); lc[32 + tid] = bs; }
            asm volatile("s_waitcnt vmcnt(0) lgkmcnt(0)" ::: "memory");
            const unsigned p0 = lc[32 + e0] + r0, p1 = lc[32 + e1] + r1;
            ((unsigned*)(ws + WS_LISTS))[(size_t)e0 * M + p0] = (unsigned)(m * 2); ((unsigned*)(ws + WS_LISTS))[(size_t)e1 * M + p1] = (unsigned)(m * 2 + 1);
            ((float*)(ws + WS_SLOTW))[(size_t)m * 2] = w0 * pgrp; ((float*)(ws + WS_SLOTW))[(size_t)m * 2 + 1] = w1 * pgrp;
        }
    }
    __syncthreads();
}

struct EpiBf16Store {
    static constexpr bool PERM = true, HAS_MID = false; bf16* O; int ldc; bf16* C2; bf16* C3;
    __device__ __forceinline__ void operator()(const pg8::f32x4 (&acc)[2][2][4][2], const pg8::Unit& u, int wr, int wc, int fr, int fq) const {
        const bool cmp = (u.pn == CMP_PN), lor = (u.pn == LOR_PN);
        bf16* base = cmp ? C2 : (lor ? C3 : O + u.pn * 256); const int ld = (cmp || lor) ? 256 : ldc;
        const int row0 = u.pm * 256 + wr * 64 + fr, col0 = wc * 32 + 8 * fq;
#pragma unroll
        for (int ai = 0; ai < 2; ++ai)
#pragma unroll
            for (int m = 0; m < 4; ++m) { bf16* rowp = base + (size_t)(row0 + ai * 128 + m * 16) * ld + col0;
#pragma unroll
                for (int bj = 0; bj < 2; ++bj) { const pg8::f32x4 v0 = acc[ai][bj][m][0], v1 = acc[ai][bj][m][1]; v4u w;
                    w.x = cvtpk(v0[0], v0[1]); w.y = cvtpk(v0[2], v0[3]); w.z = cvtpk(v1[0], v1[1]); w.w = cvtpk(v1[2], v1[3]);
                    st_wt(rowp + bj * 128, w); } }
    }
};
struct EpiLora {
    static constexpr bool PERM = false, HAS_MID = false; float* Wd; bf16 *KP, *Bv, *Gv; const bf16* KK; const float *w0, *a0, *ka;
    __device__ __forceinline__ void operator()(const pg8::f32x4 (&acc)[2][2][4][2], const pg8::Unit& u, int wr, int wc, int fr, int fq) const {
        const int row0 = u.pm * 256 + wr * 64 + fr, type = u.pn >> 1, cb = (u.pn & 1) * 256 + wc * 32 + 4 * fq;
        if (type == 0) {
#pragma unroll
            for (int bj = 0; bj < 2; ++bj)
#pragma unroll
                for (int n = 0; n < 2; ++n) { const int c = cb + bj * 128 + n * 16; const pg8::f32x4 b4 = *(const pg8::f32x4*)(w0 + c);
#pragma unroll
                    for (int ai = 0; ai < 2; ++ai)
#pragma unroll
                        for (int m = 0; m < 4; ++m) { const size_t ro = (size_t)(row0 + ai * 128 + m * 16) * CW; const pg8::f32x4 a4 = acc[ai][bj][m][n]; pg8::f32x4 o;
#pragma unroll
                            for (int i = 0; i < 4; ++i) { const float y = -(b4[i] + a4[i]); const float sp = fmaxf(y, 0.f) + __logf(1.f + __expf(-fabsf(y))); o[i] = __expf(-__expf(-sp - 0.5f)); }
                            *(pg8::f32x4*)(Wd + ro + c) = o; asm volatile("" ::: "memory"); } }
        } else if (type == 1) {
#pragma unroll
            for (int bj = 0; bj < 2; ++bj)
#pragma unroll
                for (int n = 0; n < 2; ++n) { const int c = cb + bj * 128 + n * 16; const pg8::f32x4 b4 = *(const pg8::f32x4*)(a0 + c), ka4 = *(const pg8::f32x4*)(ka + c);
#pragma unroll
                    for (int ai = 0; ai < 2; ++ai)
#pragma unroll
                        for (int m = 0; m < 4; ++m) { const size_t ro = (size_t)(row0 + ai * 128 + m * 16) * CW; const pg8::f32x4 a4 = acc[ai][bj][m][n];
                            const pg8::f32x4 k4 = ld_bf4(KP + ro + c), kk4 = ld_bf4(KK + ro + c); pg8::f32x4 o1, o2;
#pragma unroll
                            for (int i = 0; i < 4; ++i) { const float a = 1.f / (1.f + __expf(-(b4[i] + a4[i]))); o1[i] = k4[i] * (1.f + (a - 1.f) * ka4[i]); o2[i] = kk4[i] * a; }
                            *(v2u*)(KP + ro + c) = (v2u){pk2(o1[0], o1[1]), pk2(o1[2], o1[3])}; *(v2u*)(Bv + ro + c) = (v2u){pk2(o2[0], o2[1]), pk2(o2[2], o2[3])}; asm volatile("" ::: "memory"); } }
        } else {
#pragma unroll
            for (int bj = 0; bj < 2; ++bj)
#pragma unroll
                for (int n = 0; n < 2; ++n) { const int c = cb + bj * 128 + n * 16;
#pragma unroll
                    for (int ai = 0; ai < 2; ++ai)
#pragma unroll
                        for (int m = 0; m < 4; ++m) { const size_t ro = (size_t)(row0 + ai * 128 + m * 16) * CW; { const pg8::f32x4 a4 = acc[ai][bj][m][n]; *(v2u*)(Gv + ro + c) = (v2u){pk2(a4[0], a4[1]), pk2(a4[2], a4[3])}; } } }
        }
    }
};
struct EpiUpM {
    static constexpr bool PERM = true, HAS_MID = true; const bf16* Z; bf16* Mg;
    __device__ __forceinline__ void mid8(const pg8::Unit& u, int wr, int wc, int fr, int fq, int ai, int mp, pg8::f32x4 (&f)[2][2][2]) const {
        int rw = u.pm * 256 + wr * 64 + fr + ai * 128 + mp * 32; int c0 = u.pn * 256 + wc * 32 + 8 * fq; asm volatile("" : "+v"(rw), "+v"(c0));
        GAS const bf16* zb_ = (GAS const bf16*)Z; asm volatile("" : "+s"(zb_)); const bf16* zb = (const bf16*)zb_;
        v4u gr[2][2], gn[2][2];
#pragma unroll
        for (int mm = 0; mm < 2; ++mm)
#pragma unroll
            for (int bj = 0; bj < 2; ++bj) { const unsigned o = (unsigned)(rw + 16 * mm) * (unsigned)ZW + (unsigned)(c0 + bj * 128);
                gr[mm][bj] = *(const v4u*)(zb + (o + (unsigned)ZC_GRW)); gn[mm][bj] = *(const v4u*)(zb + (o + (unsigned)ZC_GNSA)); }
        __builtin_amdgcn_sched_barrier(0);
#pragma unroll
        for (int mm = 0; mm < 2; ++mm)
#pragma unroll
            for (int bj = 0; bj < 2; ++bj)
#pragma unroll
                for (int n = 0; n < 2; ++n) { const unsigned a0 = n ? gr[mm][bj].z : gr[mm][bj].x, a1 = n ? gr[mm][bj].w : gr[mm][bj].y, b0 = n ? gn[mm][bj].z : gn[mm][bj].x, b1 = n ? gn[mm][bj].w : gn[mm][bj].y;
                    const pg8::f32x4 r4 = (pg8::f32x4){bflo(a0), bfhi(a0), bflo(a1), bfhi(a1)}, n4 = (pg8::f32x4){bflo(b0), bfhi(b0), bflo(b1), bfhi(b1)};
#pragma unroll
                    for (int i = 0; i < 4; ++i) f[mm][bj][n][i] = (1.f + __builtin_amdgcn_exp2f(n4[i] * -1.4426950408889634f)) * __builtin_amdgcn_rcpf(1.f + __builtin_amdgcn_exp2f(r4[i] * -1.4426950408889634f)); }
    }
    __device__ __forceinline__ void operator()(const pg8::f32x4 (&acc)[2][2][4][2], const pg8::Unit& u, int wr, int wc, int fr, int fq) const {
        GAS const bf16* zb_ = (GAS const bf16*)Z; GAS bf16* mg_ = (GAS bf16*)Mg; asm volatile("" : "+s"(zb_), "+s"(mg_)); const bf16* zb = (const bf16*)zb_; bf16* mg = (bf16*)mg_;
        int row0 = u.pm * 256 + wr * 64 + fr; asm volatile("" : "+v"(row0)); const int col0 = u.pn * 256 + wc * 32 + 8 * fq;
#pragma unroll
        for (int ai = 0; ai < 2; ++ai) {
            v4u g[4][2];
#pragma unroll
            for (int m = 0; m < 4; ++m)
#pragma unroll
                for (int bj = 0; bj < 2; ++bj) g[m][bj] = *(const v4u*)(zb + ((unsigned)(row0 + ai * 128 + m * 16) * (unsigned)ZW + (unsigned)(ZC_GNSA + col0 + bj * 128)));
            __builtin_amdgcn_sched_barrier(0);
#pragma unroll
            for (int m = 0; m < 4; ++m) { const unsigned row = (unsigned)(row0 + ai * 128 + m * 16);
#pragma unroll
                for (int bj = 0; bj < 2; ++bj) { const v4u gg = g[m][bj]; const pg8::f32x4 a4 = acc[ai][bj][m][0], b4 = acc[ai][bj][m][1];
                    v4u w; w.x = cvtpk(a4[0] * sigmoidf_(bflo(gg.x)), a4[1] * sigmoidf_(bfhi(gg.x))); w.y = cvtpk(a4[2] * sigmoidf_(bflo(gg.y)), a4[3] * sigmoidf_(bfhi(gg.y)));
                    w.z = cvtpk(b4[0] * sigmoidf_(bflo(gg.z)), b4[1] * sigmoidf_(bfhi(gg.z))); w.w = cvtpk(b4[2] * sigmoidf_(bflo(gg.w)), b4[3] * sigmoidf_(bfhi(gg.w)));
                    st_wt(mg + (row * (unsigned)D + (unsigned)(col0 + bj * 128)), w); } }
            asm volatile("" ::: "memory"); }
    }
};
struct EpiOut {
    static constexpr bool PERM = true, HAS_MID = false; const bf16* xres; bf16* pre;
    __device__ __forceinline__ void operator()(const pg8::f32x4 (&acc)[2][2][4][2], const pg8::Unit& u, int wr, int wc, int fr, int fq) const {
        const int row0 = u.pm * 256 + wr * 64 + fr, col0 = u.pn * 256 + wc * 32 + 8 * fq;
#pragma unroll
        for (int ai = 0; ai < 2; ++ai) {
            v4u x[4][2];
#pragma unroll
            for (int m = 0; m < 4; ++m)
#pragma unroll
                for (int bj = 0; bj < 2; ++bj) x[m][bj] = *(const v4u*)(xres + (size_t)(row0 + ai * 128 + m * 16) * D + col0 + bj * 128);
            __builtin_amdgcn_sched_barrier(0);
#pragma unroll
            for (int m = 0; m < 4; ++m) { const size_t ro = (size_t)(row0 + ai * 128 + m * 16) * D;
#pragma unroll
                for (int bj = 0; bj < 2; ++bj) { const v4u xx = x[m][bj];
                    const pg8::f32x4 p0 = (pg8::f32x4){bflo(xx.x), bfhi(xx.x), bflo(xx.y), bfhi(xx.y)} * ALPHA + acc[ai][bj][m][0], p1 = (pg8::f32x4){bflo(xx.z), bfhi(xx.z), bflo(xx.w), bfhi(xx.w)} * ALPHA + acc[ai][bj][m][1];
                    st_wt(pre + ro + col0 + bj * 128, (v4u){cvtpk(p0[0], p0[1]), cvtpk(p0[2], p0[3]), cvtpk(p1[0], p1[1]), cvtpk(p1[2], p1[3])}); } }
            asm volatile("" ::: "memory"); }
    }
};
struct EpiMoe1 {
    static constexpr bool PERM = true, HAS_MID = false; bf16* H;
    __device__ __forceinline__ void operator()(const pg8::f32x4 (&acc)[2][2][4][2], const pg8::Unit& u, int wr, int wc, int fr, int fq) const {
        const int row0 = u.pm * 256 + wr * 64 + fr, col0 = u.pn * 128 + wc * 32 + 8 * fq;
#pragma unroll
        for (int ai = 0; ai < 2; ++ai)
#pragma unroll
            for (int m = 0; m < 4; ++m) { float o[8];
#pragma unroll
                for (int n = 0; n < 2; ++n)
#pragma unroll
                    for (int i = 0; i < 4; ++i) { const float a = acc[ai][0][m][n][i], b = acc[ai][1][m][n][i]; o[4 * n + i] = a * sigmoidf_(a) * b; }
                v4u w; w.x = cvtpk(o[0], o[1]); w.y = cvtpk(o[2], o[3]); w.z = cvtpk(o[4], o[5]); w.w = cvtpk(o[6], o[7]);
                st_wt(H + (size_t)(row0 + ai * 128 + m * 16) * DEXP + col0, w); }
    }
};
struct EpiMoe2 {
    static constexpr bool PERM = true, HAS_MID = false; bf16* YS; const unsigned* lists; const float* slotw;
    __device__ __forceinline__ void operator()(const pg8::f32x4 (&acc)[2][2][4][2], const pg8::Unit& u, int wr, int wc, int fr, int fq) const {
        const int col0 = u.pn * 256 + wc * 32 + 8 * fq;
        unsigned en[2][4]; float w[2][4];
#pragma unroll
        for (int ai = 0; ai < 2; ++ai)
#pragma unroll
            for (int m = 0; m < 4; ++m) { const int r = ai * 128 + wr * 64 + m * 16 + fr; en[ai][m] = lists[(size_t)u.e * M + u.mt * 256 + (r < u.rows ? r : 0)]; }
        __builtin_amdgcn_sched_barrier(0);
#pragma unroll
        for (int ai = 0; ai < 2; ++ai)
#pragma unroll
            for (int m = 0; m < 4; ++m) w[ai][m] = slotw[en[ai][m]];
        __builtin_amdgcn_sched_barrier(0);
#pragma unroll
        for (int ai = 0; ai < 2; ++ai)
#pragma unroll
            for (int m = 0; m < 4; ++m) { const int r = ai * 128 + wr * 64 + m * 16 + fr;
                if (r < u.rows) { const unsigned e1 = en[ai][m]; const float wt = w[ai][m]; bf16* op = YS + ((size_t)(e1 & 1u) * M + (e1 >> 1)) * D + col0;
#pragma unroll
                    for (int bj = 0; bj < 2; ++bj) { const pg8::f32x4 a4 = acc[ai][bj][m][0] * wt, b4 = acc[ai][bj][m][1] * wt; st_wt(op + bj * 128, (v4u){pk2(a4[0], a4[1]), pk2(a4[2], a4[3]), pk2(b4[0], b4[1]), pk2(b4[2], b4[3])}); } } }
    }
};
struct MoeOrder {
    const LAS int* tb; const LAS int* cn; const unsigned* lists; int G, c, total; size_t bstride;
    __device__ __forceinline__ bool next(int i, pg8::Unit& u) const {
        const long L = (long)i * G + c; if (L >= (long)total * 4) return false;
        const int T = (int)(L >> 2);
        const int ln = (int)__builtin_amdgcn_mbcnt_hi(~0u, __builtin_amdgcn_mbcnt_lo(~0u, 0u)); const int tv = tb[ln < NEXP ? ln : NEXP];
        const int e = (int)__popcll(__ballot(ln >= 1 && ln < NEXP && T >= tv));
        const int mt = T - tb[e]; int rows = cn[e] - mt * 256; rows = rows > 256 ? 256 : rows;
        u.pm = __builtin_amdgcn_readfirstlane(T); u.pn = __builtin_amdgcn_readfirstlane((int)(L & 3)); u.e = __builtin_amdgcn_readfirstlane(e); u.rows = __builtin_amdgcn_readfirstlane(rows); u.mt = __builtin_amdgcn_readfirstlane(mt); return true;
    }
    __device__ __forceinline__ const char* b_base(const pg8::Gemm& g, const pg8::Unit& u, size_t tstep) const { return (const char*)g.Bt + (size_t)u.e * bstride + (size_t)u.pn * tstep; }
    __device__ __forceinline__ int arow(const pg8::Unit& u, int r) const { return r < u.rows ? (int)(lists[(size_t)u.e * M + u.mt * 256 + r] >> 1) : 0; }
};

__device__ __forceinline__ void prep_unit(Frame& F, int l, int tile) {
    unsigned char* ws = wsp(F); const int lane = F.lane;
    const bf16* Z = (const bf16*)(ws + WS_LOR) + 4 * lane;
    bf16* AP = (bf16*)(ws + WS_AP);
    const f32x4 mu4 = *(const f32x4*)(inp(F, 3) + (size_t)l * 1792 + 1536 + 4 * lane);
    const int m00 = tile * 64 + 8 * F.wave;
    v2u rows[9];
#pragma unroll
    for (int i = 0; i < 9; ++i) rows[i] = (v2u){0u, 0u};
    if ((m00 & (SEQ - 1)) > 0) rows[0] = *(const v2u*)(Z + (size_t)(m00 - 1) * 256);
#pragma unroll
    for (int i = 0; i < 8; ++i) rows[i + 1] = *(const v2u*)(Z + (size_t)(m00 + i) * 256);
#pragma unroll
    for (int i = 0; i < 8; ++i) {
        const f32x4 c4 = (f32x4){bflo(rows[i + 1].x), bfhi(rows[i + 1].x), bflo(rows[i + 1].y), bfhi(rows[i + 1].y)}, p4 = (f32x4){bflo(rows[i].x), bfhi(rows[i].x), bflo(rows[i].y), bfhi(rows[i].y)};
        const f32x4 zs = c4 + (p4 - c4) * mu4; f32x4 o;
        const float sc = lane < 16 ? 2.f : 1.f;
#pragma unroll
        for (int e = 0; e < 4; ++e) { const float sg = sigmoidf_(zs[e] * sc); o[e] = lane < 16 ? 2.f * sg - 1.f : (lane < 32 ? zs[e] : sg); }
        v2u w; w.x = pk2(o.x, o.y); w.y = pk2(o.z, o.w); *(v2u*)(AP + (size_t)(m00 + i) * 256 + 4 * lane) = w; }
}

__device__ __forceinline__ float gelu_tanh(float x) { const float u = 0.7978845608028654f * (x + 0.044715f * x * x * x); return 0.5f * x * (1.f + tanhf(u)); }
__device__ __forceinline__ void compress_unit(Frame& F, int unit) {
    unsigned char* ws = wsp(F); const int lane = F.lane, w = F.wave;
    const int b = unit >> 6, which = (unit >> 5) & 1, cg = (unit >> 1) & 15, g0 = unit & 1;
    const bf16* Z = (const bf16*)(ws + WS_Z);
    const bf16* W1 = (const bf16*)(ws + (which ? WS_WC1V : WS_WC1K)); const bf16* W2 = (const bf16*)(ws + (which ? WS_WC2V : WS_WC2K));
    const float* peb = (const float*)(ws + WS_PEB) + which * 128;
    LAS bf16* hid = (LAS bf16*)F.lds;
    LAS bf16* at = (LAS bf16*)(F.lds + 8192);
    const int fr = lane & 15, fq = lane >> 4;
    for (int g = g0; g <= g0; ++g) {
        pg8::f32x4 acc = (pg8::f32x4){0.f, 0.f, 0.f, 0.f};
        const bf16* bp = W1 + (size_t)(16 * w + fr) * 2048 + 8 * fq;
#define CU_LOADB(FB, q_) do { _Pragma("unroll") for (int s_ = 0; s_ < 16; ++s_) FB[s_] = *(const bf16x8*)(bp + 32 * (16 * (q_) + s_)); } while (0)
#define CU_MMA(FB, q_) do { _Pragma("unroll") for (int s_ = 0; s_ < 16; ++s_) acc = __builtin_amdgcn_mfma_f32_16x16x32_bf16(*(const LAS bf16x8*)(at + fr * 2056 + 32 * (16 * (q_) + s_) + 8 * fq), FB[s_], acc, 0, 0, 0); } while (0)
        bf16x8 b0[16], b1[16];
        CU_LOADB(b0, 0); CU_LOADB(b1, 1);
        { const bf16* src = (const bf16*)(ws + WS_CMP) + (size_t)b * SEQ * 256 + which * 128 + g * 64; v4u pc[8];
#pragma unroll
          for (int i = 0; i < 8; ++i) { const int idx = F.tid + 512 * i, cc = idx >> 8, jj = (idx >> 3) & 31, pce = idx & 7; int cgl = 16 * cg + cc; if (cgl > 254) cgl = 254;
              pc[i] = *(const v4u*)(src + (size_t)(16 * cgl + jj) * 256 + 8 * pce); }
          __syncthreads();
#pragma unroll
          for (int i = 0; i < 8; ++i) { const int idx = F.tid + 512 * i, cc = idx >> 8, jj = (idx >> 3) & 31, pce = idx & 7; *(LAS v4u*)(at + cc * 2056 + jj * 64 + 8 * pce) = pc[i]; } }
        __syncthreads();
        __builtin_amdgcn_sched_barrier(0);
        CU_MMA(b0, 0); __builtin_amdgcn_sched_barrier(0); CU_LOADB(b0, 2); __builtin_amdgcn_sched_barrier(0);
        CU_MMA(b1, 1); __builtin_amdgcn_sched_barrier(0); CU_LOADB(b1, 3); __builtin_amdgcn_sched_barrier(0);
        CU_MMA(b0, 2); CU_MMA(b1, 3);
#undef CU_LOADB
#undef CU_MMA
        const float pb = peb[16 * w + fr];
        __syncthreads();
#pragma unroll
        for (int r = 0; r < 4; ++r) hid[(4 * fq + r) * 136 + 16 * w + fr] = (bf16)f2bf(gelu_tanh(acc[r] + pb));
        __syncthreads();
        if (w < 4) {
            pg8::f32x4 a2 = (pg8::f32x4){0.f, 0.f, 0.f, 0.f};
#pragma unroll
            for (int ks = 0; ks < 4; ++ks) {
                const bf16x8 a = *(const LAS bf16x8*)(hid + fr * 136 + 32 * ks + 8 * fq);
                const bf16x8 bb = *(const bf16x8*)(W2 + (size_t)(16 * w + fr) * 128 + 32 * ks + 8 * fq);
                a2 = __builtin_amdgcn_mfma_f32_16x16x32_bf16(a, bb, a2, 0, 0, 0);
            }
            const int d = 16 * w + fr, c0 = 16 * cg + 4 * fq;
            if (which == 0) { bf16* KC = (bf16*)(ws + WS_KC);
#pragma unroll
                for (int r = 0; r < 4; ++r) KC[((size_t)(b * 2 + g) * 256 + c0 + r) * 64 + d] = (c0 + r < NCMP) ? (bf16)f2bf(a2[r]) : (bf16)0; }
            else { bf16* VCT = (bf16*)(ws + WS_VCT); v2u o; o.x = pk2(a2[0], a2[1]); o.y = pk2(a2[2], (c0 + 3 < NCMP) ? a2[3] : 0.f);
                *(v2u*)(VCT + ((size_t)(b * 2 + g) * 64 + d) * 256 + c0) = o; }
        }
    }
    __syncthreads();
}

constexpr int CK_A1 = 0, CK_A2 = 4096, CK_A3 = 5120, CK_GC = 9216, CK_VT = 9472, CK_BYTES = 11520, NCHUNK = SEQ / 16;
template <bool INCL, bool SELF> __device__ __forceinline__ void tri_apply(const LAS float* mat, float (&y)[16], const float (&xin)[16]) {
    pg8::f32x4 nc[4], nn[4];
    constexpr int T0 = INCL ? 0 : 1;
#pragma unroll
    for (int c = 0; c < 4; ++c) if (4 * c < T0 + (INCL ? 1 : 0)) nc[c] = *(const LAS pg8::f32x4*)(mat + T0 * 16 + 4 * c);
#pragma unroll
    for (int t = T0; t < 16; ++t) {
        const int cnt = INCL ? t + 1 : t;
        if (t + 1 < 16) {
#pragma unroll
            for (int c = 0; c < 4; ++c) if (4 * c < cnt + 1) nn[c] = *(const LAS pg8::f32x4*)(mat + (t + 1) * 16 + 4 * c); }
        float a0 = y[t], a1 = 0.f;
#pragma unroll
        for (int c = 0; c < 4; ++c)
#pragma unroll
            for (int i = 0; i < 4; ++i) if (4 * c + i < cnt) { const float xv = SELF ? y[4 * c + i] : xin[4 * c + i]; if ((4 * c + i) & 1) a1 += xv * nc[c][i]; else a0 += xv * nc[c][i]; }
        y[t] = a0 + a1;
        asm volatile("" ::: "memory");
#pragma unroll
        for (int c = 0; c < 4; ++c) nc[c] = nn[c];
    }
}
__device__ __forceinline__ void chunk_prep(Frame& F, int l, const float* w0, const float* a0, const float* ka) {
    unsigned char* ws = wsp(F); const int lane = F.lane;
    bf16* KP = (bf16*)(ws + WS_S + 3 * SARR); bf16* Gv = (bf16*)(ws + WS_S + 6 * SARR);
    const bf16* AP = (const bf16*)(ws + WS_AP); const bf16* WLW = (const bf16*)(ws + WS_WLORA); const bf16* WLA = WLW + 512 * 64; const bf16* WLG = WLA + 512 * 64;
    LAS float* sc = (LAS float*)(F.lds + F.wave * 16896); LAS unsigned char* scb = (LAS unsigned char*)sc;
    constexpr int TR = 10240, TK = 12416, TV = 14592;
    LAS unsigned short* tg = (LAS unsigned short*)(scb + 8192); LAS unsigned short* trr = (LAS unsigned short*)(scb + TR); LAS unsigned short* tkp = (LAS unsigned short*)(scb + TK); LAS unsigned short* tvv = (LAS unsigned short*)(scb + TV);
    const bf16* Zb = (const bf16*)(ws + WS_Z); bf16* Ro = (bf16*)(ws + WS_S); bf16* Vo = (bf16*)(ws + WS_S + SARR);
    const int tq = lane & 15, qq = lane >> 4, tt = lane >> 2, pp = lane & 3;
    const float w0c = w0[F.wave * 64 + lane], a0c = a0[F.wave * 64 + lane], kac = ka[F.wave * 64 + lane];
    const float* mu = inp(F, 3) + (size_t)l * 1792 + F.wave * 64 + lane; const float mur = mu[0], muk = mu[512], muv = mu[1024], kkwc = (inp(F, 9) + (size_t)l * CW)[F.wave * 64 + lane];
#define CP_LOADA(FA, k4_) do { const bf16* ap_ = AP + ((size_t)(F.bid >> 6) * SEQ + ((F.bid & 63) * 4 + (k4_)) * 16 + tq) * 256 + 8 * qq; \
        _Pragma("unroll") for (int ks_ = 0; ks_ < 8; ++ks_) FA[ks_] = *(const bf16x8*)(ap_ + 32 * ks_); } while (0)
    bf16x8 fa[8];
    for (int k4 = 0; k4 < 4; ++k4) {
        const int b = F.bid >> 6, h = F.wave, ch = (F.bid & 63) * 4 + k4, bh = b * 8 + h, task = bh * NCHUNK + ch;
        const size_t wbase = ((size_t)b * SEQ + ch * 16 + tt) * CW + h * 64 + 16 * pp;
        unsigned char* rec = ws + WS_CHK + (size_t)task * CK_BYTES;
        const size_t base = ((size_t)b * SEQ + ch * 16) * CW + h * 64 + lane;
        v4u ik[6], ipv; unsigned vr[16];
        CP_LOADA(fa, k4);
        {
          LDS_WAIT(); asm volatile("" ::: "memory");
          { const bf16* zr = Zb + ((size_t)b * SEQ + ch * 16 + tt) * ZW + h * 64 + 16 * pp;
            ik[0] = *(const v4u*)(zr + ZC_R); ik[1] = *(const v4u*)(zr + ZC_R + 8); ik[2] = *(const v4u*)(zr + ZC_K); ik[3] = *(const v4u*)(zr + ZC_K + 8); ik[4] = *(const v4u*)(zr + ZC_V); ik[5] = *(const v4u*)(zr + ZC_V + 8);
            ipv = (v4u){0u, 0u, 0u, 0u};
            if (lane < 24 && ch > 0) ipv = *(const v4u*)(Zb + ((size_t)b * SEQ + ch * 16 - 1) * ZW + h * 64 + (lane >> 3) * 512 + 8 * (lane & 7)); }
#define CP_LOADQ(BW, nt_) do { const int c_ = h * 64 + 16 * (nt_) + tq; \
              _Pragma("unroll") for (int ks_ = 0; ks_ < 2; ++ks_) { BW[ks_] = *(const bf16x8*)(WLW + (size_t)c_ * 64 + 32 * ks_ + 8 * qq); BW[2 + ks_] = *(const bf16x8*)(WLA + (size_t)c_ * 64 + 32 * ks_ + 8 * qq); } \
              _Pragma("unroll") for (int ks_ = 0; ks_ < 4; ++ks_) BW[4 + ks_] = *(const bf16x8*)(WLG + (size_t)c_ * 128 + 32 * ks_ + 8 * qq); } while (0)
#define CP_MMAQ(BW, nt_) do { pg8::f32x4 dw = (pg8::f32x4){0.f, 0.f, 0.f, 0.f}, da = dw, dg = dw; \
              _Pragma("unroll") for (int ks_ = 0; ks_ < 2; ++ks_) { dw = __builtin_amdgcn_mfma_f32_16x16x32_bf16(fa[ks_], BW[ks_], dw, 0, 0, 0); da = __builtin_amdgcn_mfma_f32_16x16x32_bf16(fa[2 + ks_], BW[2 + ks_], da, 0, 0, 0); } \
              _Pragma("unroll") for (int ks_ = 0; ks_ < 4; ++ks_) dg = __builtin_amdgcn_mfma_f32_16x16x32_bf16(fa[4 + ks_], BW[4 + ks_], dg, 0, 0, 0); \
              _Pragma("unroll") for (int r_ = 0; r_ < 4; ++r_) { sc[(4 * qq + r_) * 64 + 16 * (nt_) + tq] = dw[r_]; sc[1024 + (4 * qq + r_) * 64 + 16 * (nt_) + tq] = da[r_]; tg[(4 * qq + r_) * 64 + 16 * (nt_) + tq] = (unsigned short)f2bf(dg[r_]); } } while (0)
          { bf16x8 bw0[8], bw1[8], bw2[8];
            CP_LOADQ(bw0, 0); CP_LOADQ(bw1, 1); CP_LOADQ(bw2, 2); __builtin_amdgcn_sched_barrier(0);
            CP_MMAQ(bw0, 0); __builtin_amdgcn_sched_barrier(0); CP_LOADQ(bw0, 3); __builtin_amdgcn_sched_barrier(0);
            CP_MMAQ(bw1, 1); CP_MMAQ(bw2, 2); __builtin_amdgcn_sched_barrier(0); CP_MMAQ(bw0, 3); }
#undef CP_LOADQ
#undef CP_MMAQ
          *(LAS v4u*)(scb + TR + (tt + 1) * 128 + pp * 32) = ik[0]; *(LAS v4u*)(scb + TR + (tt + 1) * 128 + pp * 32 + 16) = ik[1];
          *(LAS v4u*)(scb + TK + (tt + 1) * 128 + pp * 32) = ik[2]; *(LAS v4u*)(scb + TK + (tt + 1) * 128 + pp * 32 + 16) = ik[3];
          *(LAS v4u*)(scb + TV + (tt + 1) * 128 + pp * 32) = ik[4]; *(LAS v4u*)(scb + TV + (tt + 1) * 128 + pp * 32 + 16) = ik[5];
          if (lane < 24) *(LAS v4u*)(scb + TR + (lane >> 3) * (TK - TR) + (lane & 7) * 16) = ipv;
          LDS_WAIT(); asm volatile("" ::: "memory"); }
        float al[16], be[16], kb[16], rb[16];
        float g = 1.f;
        { float pr = bf2f(trr[lane]), pk = bf2f(tkp[lane]), pv = bf2f(tvv[lane]);
#pragma unroll
          for (int t = 0; t < 16; ++t) {
              const float cr = bf2f(trr[(t + 1) * 64 + lane]), ck = bf2f(tkp[(t + 1) * 64 + lane]), cv = bf2f(tvv[(t + 1) * 64 + lane]);
              const float rsh = cr + (pr - cr) * mur, kraw = ck + (pk - ck) * muk, vsh = cv + (pv - cv) * muv; pr = cr; pk = ck; pv = cv;
              const unsigned rvb = cvtpk(rsh, vsh); const float rv = bflo(rvb); vr[t] = rvb >> 16;
              trr[(t + 1) * 64 + lane] = (unsigned short)rvb; tvv[(t + 1) * 64 + lane] = (unsigned short)(rvb >> 16);
              const float kq = kraw * kkwc; const float kkv = kq * __builtin_amdgcn_rcpf(fmaxf(__builtin_amdgcn_sqrtf(wave_sum(kq * kq)), 1e-12f));
              const float yw = -(w0c + sc[t * 64 + lane]); const float sp = fmaxf(yw, 0.f) + __logf(1.f + __expf(-fabsf(yw))); const float wv = __expf(-__expf(-sp - 0.5f));
              const float av = __builtin_amdgcn_rcpf(1.f + __expf(-(a0c + sc[1024 + t * 64 + lane]))); const float bv = kkv * av, kpv = kraw * (1.f + (av - 1.f) * kac);
              tkp[(t + 1) * 64 + lane] = (unsigned short)f2bf(kpv);
              al[t] = -kkv * g; g *= wv; const float ig = __builtin_amdgcn_rcpf(g); be[t] = bv * ig; kb[t] = kpv * ig; rb[t] = rv * g; }
          *(v4u*)(rec + CK_VT + lane * 32) = (v4u){vr[0] | (vr[1] << 16), vr[2] | (vr[3] << 16), vr[4] | (vr[5] << 16), vr[6] | (vr[7] << 16)};
          *(v4u*)(rec + CK_VT + lane * 32 + 16) = (v4u){vr[8] | (vr[9] << 16), vr[10] | (vr[11] << 16), vr[12] | (vr[13] << 16), vr[14] | (vr[15] << 16)}; }
        ((float*)(rec + CK_GC))[lane] = g;
        LDS_WAIT(); asm volatile("" ::: "memory");
        { const v4u o0 = *(const LAS v4u*)(scb + TK + (tt + 1) * 128 + pp * 32), o1 = *(const LAS v4u*)(scb + TK + (tt + 1) * 128 + pp * 32 + 16), g0 = *(const LAS v4u*)(scb + 8192 + tt * 128 + pp * 32), g1 = *(const LAS v4u*)(scb + 8192 + tt * 128 + pp * 32 + 16);
          const v4u r0 = *(const LAS v4u*)(scb + TR + (tt + 1) * 128 + pp * 32), r1 = *(const LAS v4u*)(scb + TR + (tt + 1) * 128 + pp * 32 + 16), v0 = *(const LAS v4u*)(scb + TV + (tt + 1) * 128 + pp * 32), v1 = *(const LAS v4u*)(scb + TV + (tt + 1) * 128 + pp * 32 + 16);
          *(v4u*)(KP + wbase) = o0; *(v4u*)(KP + wbase + 8) = o1; *(v4u*)(Gv + wbase) = g0; *(v4u*)(Gv + wbase + 8) = g1;
          *(v4u*)(Ro + wbase) = r0; *(v4u*)(Ro + wbase + 8) = r1; *(v4u*)(Vo + wbase) = v0; *(v4u*)(Vo + wbase + 8) = v1; }
#pragma unroll
        for (int q = 0; q < 4; ++q) { v4u o; o.x = pk2(be[4 * q] * g, be[4 * q + 1] * g); o.y = pk2(be[4 * q + 2] * g, be[4 * q + 3] * g); o.z = pk2(kb[4 * q] * g, kb[4 * q + 1] * g); o.w = pk2(kb[4 * q + 2] * g, kb[4 * q + 3] * g);
            *(v4u*)(rec + CK_A3 + lane * 64 + 16 * q) = o; }
        LDS_WAIT(); asm volatile("" ::: "memory");
        { LAS unsigned short* ob = (LAS unsigned short*)scb;
#pragma unroll
          for (int t = 0; t < 16; ++t) { const unsigned p0 = cvtpk(be[t], kb[t]), p1 = cvtpk(al[t], rb[t]);
              ob[t * 72 + lane] = (unsigned short)p0; ob[1152 + t * 72 + lane] = (unsigned short)(p0 >> 16); ob[2304 + t * 72 + lane] = (unsigned short)p1; ob[3456 + t * 72 + lane] = (unsigned short)(p1 >> 16); } }
        LDS_WAIT(); asm volatile("" ::: "memory");
        pg8::f32x4 cab = (pg8::f32x4){0.f, 0.f, 0.f, 0.f}, cak = cab, crb = cab, crk = cab;
        { const LAS bf16* ob = (const LAS bf16*)scb + tq * 72 + 8 * qq;
#pragma unroll
          for (int kh = 0; kh < 2; ++kh) {
              const bf16x8 fbe = *(const LAS bf16x8*)(ob + 32 * kh), fkb = *(const LAS bf16x8*)(ob + 1152 + 32 * kh), fal = *(const LAS bf16x8*)(ob + 2304 + 32 * kh), frb = *(const LAS bf16x8*)(ob + 3456 + 32 * kh);
              cab = __builtin_amdgcn_mfma_f32_16x16x32_bf16(fbe, fal, cab, 0, 0, 0); cak = __builtin_amdgcn_mfma_f32_16x16x32_bf16(fkb, fal, cak, 0, 0, 0);
              crb = __builtin_amdgcn_mfma_f32_16x16x32_bf16(fbe, frb, crb, 0, 0, 0); crk = __builtin_amdgcn_mfma_f32_16x16x32_bf16(fkb, frb, crk, 0, 0, 0); } }
        LDS_WAIT(); asm volatile("" ::: "memory");
        { pg8::f32x4 m1, m2, m3, m4;
#pragma unroll
          for (int r = 0; r < 4; ++r) { const int i = 4 * qq + r; m1[r] = (i < tq) ? cab[r] : 0.f; m2[r] = (i < tq) ? cak[r] : 0.f; m3[r] = (i <= tq) ? crb[r] : 0.f; m4[r] = (i <= tq) ? crk[r] : 0.f; }
          *(LAS pg8::f32x4*)(sc + tq * 16 + 4 * qq) = m1; *(LAS pg8::f32x4*)(sc + 256 + tq * 16 + 4 * qq) = m2; *(LAS pg8::f32x4*)(sc + 512 + tq * 16 + 4 * qq) = m3; *(LAS pg8::f32x4*)(sc + 768 + tq * 16 + 4 * qq) = m4; }
        LDS_WAIT(); asm volatile("" ::: "memory");
        tri_apply<false, true>(sc, al, al);
        tri_apply<true, false>(sc + 512, rb, al);
        { const int pos = (lane & 32) + 8 * ((lane >> 2) & 3) + 4 * ((lane >> 4) & 1) + (lane & 3); LAS unsigned short* a1 = (LAS unsigned short*)(scb + 4096);
#pragma unroll
          for (int t = 0; t < 16; ++t) { a1[t * 64 + pos] = (unsigned short)f2bf(al[t]); a1[(16 + t) * 64 + pos] = (unsigned short)f2bf(rb[t]); } }
        if (lane < 16) { float pk[16], qv[16];
#pragma unroll
            for (int t = 0; t < 16; ++t) { pk[t] = sc[256 + t * 16 + lane]; qv[t] = sc[768 + t * 16 + lane]; }
            asm volatile("" ::: "memory");
            tri_apply<false, true>(sc, pk, pk);
            tri_apply<true, false>(sc + 512, qv, pk);
            LAS unsigned short* a2 = (LAS unsigned short*)(scb + 8192);
#pragma unroll
            for (int t = 0; t < 16; ++t) { a2[t * 16 + lane] = (unsigned short)f2bf(pk[t]); a2[(16 + t) * 16 + lane] = (unsigned short)f2bf(qv[t]); } }
        LDS_WAIT(); asm volatile("" ::: "memory");
#pragma unroll
        for (int i = 0; i < 4; ++i) *(v4u*)(rec + CK_A1 + (lane + 64 * i) * 16) = *(const LAS v4u*)(scb + 4096 + (lane + 64 * i) * 16);
        *(v4u*)(rec + CK_A2 + lane * 16) = *(const LAS v4u*)(scb + 8192 + lane * 16);
    }
#undef CP_LOADA
}
constexpr int CSCAN_BLOCKS = 32, CK_STAGE = 4 * CK_BYTES, CK_PIECES = CK_STAGE / 16, CK_NST = NCHUNK / 4;
__device__ __forceinline__ v2u cvt4_bf16(const pg8::f32x4& x) { v2u r; r.x = cvtpk(x[0], x[1]); r.y = cvtpk(x[2], x[3]); return r; }
__device__ __forceinline__ void chunk_scan(Frame& F, int l) {
    unsigned char* ws = wsp(F); const int lane = F.lane, w = F.wave, tid = F.tid;
    if (F.bid >= CSCAN_BLOCKS) return;
    const int bh = F.bid, b = bh >> 3, h = bh & 7, fr = lane & 15, q = lane >> 4;
    LAS float* ybuf = (LAS float*)(F.lds + 2 * CK_STAGE);
    const unsigned char* rec = ws + WS_CHK + (size_t)bh * NCHUNK * CK_BYTES;
    pg8::f32x4 st[4];
#pragma unroll
    for (int kt = 0; kt < 4; ++kt) st[kt] = (pg8::f32x4){0.f, 0.f, 0.f, 0.f};
    const bf16x8 zero8 = (bf16x8){0, 0, 0, 0, 0, 0, 0, 0};
    v4u ra[6], rb[6];
#define CS_LOAD(dst, s) do { _Pragma("unroll") for (int i = 0; i < 6; ++i) { const int idx = tid + 512 * i; if (idx < CK_PIECES) dst[i] = *(const v4u*)(rec + (size_t)(s) * CK_STAGE + (size_t)idx * 16); } } while (0)
#define CS_STORE(src, pb) do { _Pragma("unroll") for (int i = 0; i < 6; ++i) { const int idx = tid + 512 * i; if (idx < CK_PIECES) *(LAS v4u*)(F.lds + (pb) * CK_STAGE + idx * 16) = src[i]; } } while (0)
    const int ptk = (w - 4) * 16 + (lane >> 2), pc0 = h * 64 + (lane & 3) * 16;
    LAS float* prm = (LAS float*)(F.lds + 2 * CK_STAGE + 32768);
    if (tid < 192) prm[tid] = (inp(F, tid < 64 ? 12 : (tid < 128 ? 13 : 11)) + (size_t)l * CW)[h * 64 + (tid & 63)];
    v4u pr_[2], pk_[2], pv_[2], pg_[2];
#define CS_POST_LOAD(sp) do { if (w >= 4) { const size_t o_ = ((size_t)b * SEQ + (sp) * 64 + ptk) * CW + pc0; \
        _Pragma("unroll") for (int i_ = 0; i_ < 2; ++i_) { pr_[i_] = *(const v4u*)((const bf16*)(ws + WS_S) + o_ + 8 * i_); pk_[i_] = *(const v4u*)((const bf16*)(ws + WS_S + 3 * SARR) + o_ + 8 * i_); \
            pv_[i_] = *(const v4u*)((const bf16*)(ws + WS_S + SARR) + o_ + 8 * i_); pg_[i_] = *(const v4u*)((const bf16*)(ws + WS_S + 6 * SARR) + o_ + 8 * i_); } } } while (0)
#define CS_POST_RUN(sp) do { if (w >= 4) { const LAS float* lg_ = prm + (lane & 3) * 16; const LAS float* lb_ = lg_ + 64; const LAS float* rk_ = lg_ + 128; \
        float y_[16], s_ = 0.f, bn_ = 0.f; \
        _Pragma("unroll") for (int i_ = 0; i_ < 4; ++i_) { const f32x4 t_ = *(const LAS f32x4*)(ybuf + (((sp) & 1) * 64 + ptk) * 64 + (lane & 3) * 16 + 4 * i_); y_[4 * i_] = t_.x; y_[4 * i_ + 1] = t_.y; y_[4 * i_ + 2] = t_.z; y_[4 * i_ + 3] = t_.w; } \
        const unsigned rr_[8] = {pr_[0].x, pr_[0].y, pr_[0].z, pr_[0].w, pr_[1].x, pr_[1].y, pr_[1].z, pr_[1].w}, kk_[8] = {pk_[0].x, pk_[0].y, pk_[0].z, pk_[0].w, pk_[1].x, pk_[1].y, pk_[1].z, pk_[1].w}; \
        const unsigned vv_[8] = {pv_[0].x, pv_[0].y, pv_[0].z, pv_[0].w, pv_[1].x, pv_[1].y, pv_[1].z, pv_[1].w}, gg_[8] = {pg_[0].x, pg_[0].y, pg_[0].z, pg_[0].w, pg_[1].x, pg_[1].y, pg_[1].z, pg_[1].w}; \
        _Pragma("unroll") for (int i_ = 0; i_ < 8; ++i_) { s_ += y_[2 * i_] + y_[2 * i_ + 1]; bn_ += bflo(rr_[i_]) * bflo(kk_[i_]) * rk_[2 * i_] + bfhi(rr_[i_]) * bfhi(kk_[i_]) * rk_[2 * i_ + 1]; } \
        const float mu_ = sum4(s_) * (1.f / 64.f); bn_ = sum4(bn_); float q_ = 0.f; \
        _Pragma("unroll") for (int i_ = 0; i_ < 16; ++i_) { y_[i_] -= mu_; q_ += y_[i_] * y_[i_]; } \
        const float rstd_ = 1.f / sqrtf(sum4(q_) * (1.f / 64.f) + GN_EPS); unsigned o8_[8]; \
        _Pragma("unroll") for (int i_ = 0; i_ < 8; ++i_) { const float a_ = (y_[2 * i_] * rstd_ * lg_[2 * i_] + lb_[2 * i_] + bn_ * bflo(vv_[i_])) * bflo(gg_[i_]), b_ = (y_[2 * i_ + 1] * rstd_ * lg_[2 * i_ + 1] + lb_[2 * i_ + 1] + bn_ * bfhi(vv_[i_])) * bfhi(gg_[i_]); o8_[i_] = pk2(a_, b_); } \
        bf16* yo_ = (bf16*)(ws + WS_YRW) + ((size_t)b * SEQ + (sp) * 64 + ptk) * D + pc0; *(v4u*)yo_ = (v4u){o8_[0], o8_[1], o8_[2], o8_[3]}; *(v4u*)(yo_ + 8) = (v4u){o8_[4], o8_[5], o8_[6], o8_[7]}; } } while (0)
    __syncthreads();
    CS_LOAD(rb, 0); CS_STORE(rb, 0); CS_LOAD(rb, 1); CS_POST_LOAD(0);
    __syncthreads();
    for (int s2 = 0; s2 < CK_NST; s2 += 2) {
        { const int s = s2;
          if (s + 2 < CK_NST) CS_LOAD(ra, s + 2);
          if (s > 0) { CS_POST_RUN(s - 1); CS_POST_LOAD(s); }
        if (w < 4) {
            for (int c = 0; c < 4; ++c) {
                const LAS unsigned char* rp = F.lds + (s & 1) * CK_STAGE + c * CK_BYTES;
                bf16x8 c1[2][2], c2[2], c3[4], cv8; v2u cv4; pg8::f32x4 cg[4];
#pragma unroll
                for (int mt = 0; mt < 2; ++mt) {
#pragma unroll
                    for (int ks = 0; ks < 2; ++ks) c1[mt][ks] = *(const LAS bf16x8*)(rp + CK_A1 + ((16 * mt + fr) * 64 + 32 * ks + 8 * q) * 2);
                    c2[mt] = *(const LAS bf16x8*)(rp + CK_A2 + ((16 * mt + fr) * 16 + 8 * (q & 1)) * 2); if (q >= 2) c2[mt] = zero8; }
#pragma unroll
                for (int kt = 0; kt < 4; ++kt) { c3[kt] = *(const LAS bf16x8*)(rp + CK_A3 + ((16 * kt + fr) * 32 + 8 * q) * 2); cg[kt] = *(const LAS pg8::f32x4*)(rp + CK_GC + (16 * kt + 4 * q) * 4); }
                cv8 = *(const LAS bf16x8*)(rp + CK_VT + ((16 * w + fr) * 16 + 8 * (q & 1)) * 2); if (q >= 2) cv8 = zero8;
                cv4 = *(const LAS v2u*)(rp + CK_VT + ((16 * w + fr) * 16 + 4 * q) * 2);
                bf16x8 sb[2];
#pragma unroll
                for (int ks = 0; ks < 2; ++ks) { const v2u lo = cvt4_bf16(st[2 * ks]), hi = cvt4_bf16(st[2 * ks + 1]); sb[ks] = __builtin_bit_cast(bf16x8, (v4u){lo.x, lo.y, hi.x, hi.y}); }
                pg8::f32x4 d[2];
#pragma unroll
                for (int mt = 0; mt < 2; ++mt) { d[mt] = (pg8::f32x4){0.f, 0.f, 0.f, 0.f};
                    d[mt] = __builtin_amdgcn_mfma_f32_16x16x32_bf16(c2[mt], cv8, d[mt], 0, 0, 0);
                    d[mt] = __builtin_amdgcn_mfma_f32_16x16x32_bf16(c1[mt][0], sb[0], d[mt], 0, 0, 0);
                    d[mt] = __builtin_amdgcn_mfma_f32_16x16x32_bf16(c1[mt][1], sb[1], d[mt], 0, 0, 0); }
#pragma unroll
                for (int r = 0; r < 4; ++r) ybuf[((s & 1) * 64 + c * 16 + 4 * q + r) * 64 + 16 * w + fr] = d[1][r];
                { const v2u ul = cvt4_bf16(d[0]); const bf16x8 ub = __builtin_bit_cast(bf16x8, (v4u){ul.x, ul.y, cv4.x, cv4.y});
#pragma unroll
                  for (int kt = 0; kt < 4; ++kt) { st[kt] = st[kt] * cg[kt]; st[kt] = __builtin_amdgcn_mfma_f32_16x16x32_bf16(c3[kt], ub, st[kt], 0, 0, 0); } }
            }
        }
          if (s + 1 < CK_NST) CS_STORE(rb, (s + 1) & 1);
          __syncthreads(); }
        { const int s = s2 + 1;
          if (s + 2 < CK_NST) CS_LOAD(rb, s + 2);
          CS_POST_RUN(s - 1); CS_POST_LOAD(s);
        if (w < 4) {
            for (int c = 0; c < 4; ++c) {
                const LAS unsigned char* rp = F.lds + (s & 1) * CK_STAGE + c * CK_BYTES;
                bf16x8 c1[2][2], c2[2], c3[4], cv8; v2u cv4; pg8::f32x4 cg[4];
#pragma unroll
                for (int mt = 0; mt < 2; ++mt) {
#pragma unroll
                    for (int ks = 0; ks < 2; ++ks) c1[mt][ks] = *(const LAS bf16x8*)(rp + CK_A1 + ((16 * mt + fr) * 64 + 32 * ks + 8 * q) * 2);
                    c2[mt] = *(const LAS bf16x8*)(rp + CK_A2 + ((16 * mt + fr) * 16 + 8 * (q & 1)) * 2); if (q >= 2) c2[mt] = zero8; }
#pragma unroll
                for (int kt = 0; kt < 4; ++kt) { c3[kt] = *(const LAS bf16x8*)(rp + CK_A3 + ((16 * kt + fr) * 32 + 8 * q) * 2); cg[kt] = *(const LAS pg8::f32x4*)(rp + CK_GC + (16 * kt + 4 * q) * 4); }
                cv8 = *(const LAS bf16x8*)(rp + CK_VT + ((16 * w + fr) * 16 + 8 * (q & 1)) * 2); if (q >= 2) cv8 = zero8;
                cv4 = *(const LAS v2u*)(rp + CK_VT + ((16 * w + fr) * 16 + 4 * q) * 2);
                bf16x8 sb[2];
#pragma unroll
                for (int ks = 0; ks < 2; ++ks) { const v2u lo = cvt4_bf16(st[2 * ks]), hi = cvt4_bf16(st[2 * ks + 1]); sb[ks] = __builtin_bit_cast(bf16x8, (v4u){lo.x, lo.y, hi.x, hi.y}); }
                pg8::f32x4 d[2];
#pragma unroll
                for (int mt = 0; mt < 2; ++mt) { d[mt] = (pg8::f32x4){0.f, 0.f, 0.f, 0.f};
                    d[mt] = __builtin_amdgcn_mfma_f32_16x16x32_bf16(c2[mt], cv8, d[mt], 0, 0, 0);
                    d[mt] = __builtin_amdgcn_mfma_f32_16x16x32_bf16(c1[mt][0], sb[0], d[mt], 0, 0, 0);
                    d[mt] = __builtin_amdgcn_mfma_f32_16x16x32_bf16(c1[mt][1], sb[1], d[mt], 0, 0, 0); }
#pragma unroll
                for (int r = 0; r < 4; ++r) ybuf[((s & 1) * 64 + c * 16 + 4 * q + r) * 64 + 16 * w + fr] = d[1][r];
                { const v2u ul = cvt4_bf16(d[0]); const bf16x8 ub = __builtin_bit_cast(bf16x8, (v4u){ul.x, ul.y, cv4.x, cv4.y});
#pragma unroll
                  for (int kt = 0; kt < 4; ++kt) { st[kt] = st[kt] * cg[kt]; st[kt] = __builtin_amdgcn_mfma_f32_16x16x32_bf16(c3[kt], ub, st[kt], 0, 0, 0); } }
            }
        }
          if (s + 1 < CK_NST) CS_STORE(ra, (s + 1) & 1);
          __syncthreads(); }
    }
    CS_POST_RUN(CK_NST - 1);
    __syncthreads();
#undef CS_POST_RUN
#undef CS_POST_LOAD
#undef CS_LOAD
#undef CS_STORE
}

constexpr int AT_KS = 0, AT_VT = 9216, AT_BUF = 18432, AT_LUT = 36864, AT_LUTP = 1032, AT_PS = 53376, AT_SEL = 118912, AT_UNI = 119424;
constexpr float AT_C = 0.125f * 1.4426950408889634f;
__device__ __forceinline__ int crow(int r, int h) { return (r & 3) + 8 * (r >> 2) + 4 * h; }

__device__ __forceinline__ void at_load(Frame& F, const bf16* kb, size_t ldk, const bf16* vb, size_t ldv, v4u& kw, v4u& vw) {
    const int r = F.tid >> 3, p = F.tid & 7;
    kw = *(const v4u*)(kb + (size_t)r * ldk + 8 * p);
    vw = *(const v4u*)(vb + (size_t)r * ldv + 8 * p);
}
template <bool VROWMAJOR> __device__ __forceinline__ void at_commit(Frame& F, const v4u& kw, const v4u& vw, int& nb) {
    const int r = F.tid >> 3, p = F.tid & 7; LAS unsigned char* bb = F.lds + (nb & 1) * AT_BUF; ++nb;
    *(LAS v4u*)(bb + AT_KS + (r * 72 + 8 * p) * 2) = kw;
    if (VROWMAJOR) {
        LAS bf16* vt = (LAS bf16*)(bb + AT_VT);
        vt[(8 * p + 0) * 72 + r] = (bf16)(vw.x & 0xffffu); vt[(8 * p + 1) * 72 + r] = (bf16)(vw.x >> 16);
        vt[(8 * p + 2) * 72 + r] = (bf16)(vw.y & 0xffffu); vt[(8 * p + 3) * 72 + r] = (bf16)(vw.y >> 16);
        vt[(8 * p + 4) * 72 + r] = (bf16)(vw.z & 0xffffu); vt[(8 * p + 5) * 72 + r] = (bf16)(vw.z >> 16);
        vt[(8 * p + 6) * 72 + r] = (bf16)(vw.w & 0xffffu); vt[(8 * p + 7) * 72 + r] = (bf16)(vw.w >> 16);
    } else {
        *(LAS v4u*)(bb + AT_VT + (r * 72 + 8 * p) * 2) = vw;
    }
    __syncthreads();
}
template <int BR> __device__ __forceinline__ void at_scores(Frame& F, const bf16x8 (&qf)[4], int kb0, int t, int hd, bool laneok, int path, int nb, int kt, f32x16& sc) {
    const int lane = F.lane, h = lane >> 5, r32 = lane & 31; const LAS unsigned char* bb = F.lds + ((nb - 1) & 1) * AT_BUF;
    const LAS float* lut = (const LAS float*)(F.lds + AT_LUT) + hd * AT_LUTP;
    f32x16 a;
#pragma unroll
    for (int i = 0; i < 16; ++i) a[i] = 0.f;
    bf16x8 kf[4];
#pragma unroll
    for (int s = 0; s < 4; ++s) kf[s] = *(const LAS bf16x8*)(bb + AT_KS + ((32 * kt + r32) * 72 + 16 * s + 8 * h) * 2);
    __builtin_amdgcn_sched_barrier(0);
#pragma unroll
    for (int s = 0; s < 4; ++s) a = __builtin_amdgcn_mfma_f32_32x32x16_bf16(kf[s], qf[s], a, 0, 0, 0);
    if (BR != 2 && path == 1) {
        const float add = laneok ? lut[1023] : -__builtin_inff();
#pragma unroll
        for (int r = 0; r < 16; ++r) sc[r] = a[r] * AT_C + add;
        return;
    }
    if (BR != 0 && path == 2) {
        const float neg = laneok ? 0.f : -__builtin_inff(); const LAS float* lq = lut + (t - kb0 - 32 * kt - 4 * h);
#pragma unroll
        for (int r = 0; r < 16; ++r) sc[r] = (a[r] * AT_C + lq[-((r & 3) + 8 * (r >> 2))]) + neg;
        return;
    }
#pragma unroll
    for (int r = 0; r < 16; ++r) {
        const int key = kb0 + 32 * kt + crow(r, h); const int dist = (BR == 0) ? t - 16 * key - 31 : t - key;
        int di = dist < 0 ? 0 : dist; di = di > 1023 ? 1023 : di;
        sc[r] = lut[di];
    }
    __builtin_amdgcn_sched_barrier(0);
#pragma unroll
    for (int r = 0; r < 16; ++r) {
        const int key = kb0 + 32 * kt + crow(r, h); int dist; bool ok;
        if (BR == 0) { dist = t - 16 * key - 31; ok = (dist >= 0) && (key < NCMP); }
        else if (BR == 1) { dist = t - key; ok = laneok && (dist >= 0); }
        else { dist = t - key; ok = (dist >= 0) && (dist < 512); }
        const float v = a[r] * AT_C + sc[r];
        sc[r] = ok ? v : -__builtin_inff();
    }
}
__device__ __forceinline__ bf16x8 pack8(const f32x16& x, int s) {
    v4u p; p.x = cvtpk(x[8 * s], x[8 * s + 1]); p.y = cvtpk(x[8 * s + 2], x[8 * s + 3]); p.z = cvtpk(x[8 * s + 4], x[8 * s + 5]); p.w = cvtpk(x[8 * s + 6], x[8 * s + 7]);
    return __builtin_bit_cast(bf16x8, p);
}
__device__ __forceinline__ void at_accum(Frame& F, f32x16& sc, float& m_run, float& l_run, f32x16 (&O)[2], int nb, int kt) {
    const int lane = F.lane, h = lane >> 5, r32 = lane & 31; const LAS unsigned char* bb = F.lds + ((nb - 1) & 1) * AT_BUF;
    bf16x8 vf[2][2];
#pragma unroll
    for (int s = 0; s < 2; ++s)
#pragma unroll
        for (int dt = 0; dt < 2; ++dt) { const LAS unsigned char* vp = bb + AT_VT + ((32 * dt + r32) * 72 + 32 * kt + 16 * s + 4 * h) * 2;
            const s16x4 lo = *(const LAS s16x4*)(vp), hi = *(const LAS s16x4*)(vp + 16); vf[s][dt] = __builtin_shufflevector(lo, hi, 0, 1, 2, 3, 4, 5, 6, 7); }
    __builtin_amdgcn_sched_barrier(0);
    float mx = -__builtin_inff();
#pragma unroll
    for (int r = 0; r < 16; ++r) mx = fmaxf(mx, sc[r]);
    mx = x32_max(mx);
    const float m_new = fmaxf(m_run, mx);
    const float alpha = __builtin_amdgcn_exp2f(m_run - m_new);
    float rs = 0.f;
#pragma unroll
    for (int r = 0; r < 16; ++r) { const float p = __builtin_amdgcn_exp2f(sc[r] - m_new); sc[r] = p; rs += p; }
    rs = x32_sum(rs);
    l_run = l_run * alpha + rs; m_run = m_new;
    if (__ballot(alpha != 1.f) != 0ull) {
#pragma unroll
        for (int dt = 0; dt < 2; ++dt)
#pragma unroll
            for (int i = 0; i < 16; ++i) O[dt][i] *= alpha;
    }
#pragma unroll
    for (int s = 0; s < 2; ++s) {
        bf16x8 pf = pack8(sc, s);
#pragma unroll
        for (int dt = 0; dt < 2; ++dt) O[dt] = __builtin_amdgcn_mfma_f32_32x32x16_bf16(vf[s][dt], pf, O[dt], 0, 0, 0);
    }
}
template <int MODE> __device__ __forceinline__ void at_finish(Frame& F, float gate, float l_run, f32x16 (&O)[2], LAS float* slab) {
    const float sc = l_run > 0.f ? gate / l_run : 0.f;
#pragma unroll
    for (int dt = 0; dt < 2; ++dt)
#pragma unroll
        for (int i = 0; i < 16; ++i) { LAS float* sp = slab + (dt * 16 + i) * NT; float v = (sc != 0.f) ? O[dt][i] * sc : 0.f;
            if (MODE != 0) v += *sp;
            if (MODE != 2) { *sp = v; O[dt][i] = 0.f; } else O[dt][i] = v; }
}
__device__ __forceinline__ void attn_unit(Frame& F, int b, int g, int qt) {
    unsigned char* ws = wsp(F); const int lane = F.lane, w = F.wave, tid = F.tid, h = lane >> 5, r32 = lane & 31;
    const bf16* Z = (const bf16*)(ws + WS_Z);
    const int t0 = 64 * qt, tl = r32 >> 2, hd = r32 & 3, t = t0 + 8 * w + tl;
    const size_t mrow = (size_t)b * SEQ + t;
    LAS float* ps = (LAS float*)(F.lds + AT_PS);
    LAS unsigned long long* selm = (LAS unsigned long long*)(F.lds + AT_SEL);
    LAS unsigned long long* unim = (LAS unsigned long long*)(F.lds + AT_UNI);
    __syncthreads();
    { const float* lut = (const float*)(ws + WS_LUT) + (size_t)(g * 4) * 1024; LAS float* ll = (LAS float*)(F.lds + AT_LUT);
#pragma unroll
      for (int i = 0; i < 2; ++i) { const int e = 4 * (tid + 512 * i); *(LAS f32x4*)(ll + e + (e >> 10) * (AT_LUTP - 1024)) = *(const f32x4*)(lut + e); }
#pragma unroll
      for (int i = 0; i < 8; ++i) *(LAS f32x4*)(ps + 4 * (tid + 512 * i)) = (f32x4){0.f, 0.f, 0.f, 0.f}; }
    bf16x8 qf[4];
#pragma unroll
    for (int s = 0; s < 4; ++s) qf[s] = *(const bf16x8*)(Z + mrow * ZW + ZC_Q + (g * 4 + hd) * 64 + 16 * s + 8 * h);
    const float* gt = (const float*)(ws + WS_GATES) + mrow * 24 + g * 12 + hd * 3;
    f32x16 O[2], sc; LAS float* slab = (LAS float*)(F.lds + AT_PS) + tid;
#pragma unroll
    for (int dt = 0; dt < 2; ++dt)
#pragma unroll
        for (int i = 0; i < 16; ++i) O[dt][i] = 0.f;
    float m_run = -1e30f, l_run = 0.f;
    const int tmax = t0 + 63; const int ncb = (tmax >= 31) ? (((tmax - 31) >> 4) >> 6) + 1 : 0;
    const bf16* KC = (const bf16*)(ws + WS_KC) + (size_t)(b * 2 + g) * 256 * 64; const bf16* VCT = (const bf16*)(ws + WS_VCT) + (size_t)(b * 2 + g) * 64 * 256;
    v4u kw, vw; int nb = 0;
    at_load(F, KC, 64, VCT, 256, kw, vw);
    for (int cb = 0; cb < ncb; ++cb) {
        at_commit<false>(F, kw, vw, nb);
        { const int nx = (cb + 1 < ncb) ? cb + 1 : 0; at_load(F, KC + (size_t)nx * 64 * 64, 64, VCT + nx * 64, 256, kw, vw); }
#pragma unroll
        for (int kt = 0; kt < 2; ++kt) { at_scores<0>(F, qf, cb * 64, t, hd, true, (t0 - 16 * (cb * 64 + 32 * kt + 31) - 31 >= 790 && cb * 64 + 32 * kt + 31 < NCMP) ? 1 : 0, nb, kt, sc); at_accum(F, sc, m_run, l_run, O, nb, kt); }
    }
    const float m_c = m_run, il_c = l_run > 0.f ? 1.f / l_run : 0.f;
    const float l_c = l_run;
    for (int cb = 0; cb < ncb; ++cb) {
        at_commit<false>(F, kw, vw, nb);
        if (cb + 1 < ncb) at_load(F, KC + (size_t)(cb + 1) * 64 * 64, 64, VCT + (cb + 1) * 64, 256, kw, vw);
#pragma unroll
        for (int kt = 0; kt < 2; ++kt) { at_scores<0>(F, qf, cb * 64, t, hd, true, (t0 - 16 * (cb * 64 + 32 * kt + 31) - 31 >= 790 && cb * 64 + 32 * kt + 31 < NCMP) ? 1 : 0, nb, kt, sc);
#pragma unroll
            for (int r = 0; r < 16; ++r) { float p = __builtin_amdgcn_exp2f(sc[r] - m_c) * il_c; p = sum4(p);
                if (hd == 0) ps[(8 * w + tl) * 256 + cb * 64 + 32 * kt + crow(r, h)] = p; } }
    }
    __syncthreads();
    unsigned long long myu = 0ull;
    for (int k = 0; k < 8; ++k) {
        const LAS float* pr = ps + (8 * w + k) * 256; const int j = lane;
        const f32x4 p4 = *(const LAS f32x4*)(pr + 4 * j); const float pm1 = (j > 0) ? pr[4 * j - 1] : 0.f;
        const float score = (p4.x + p4.y) + p4.z + 0.5f * (p4.w + pm1);
        const bool forced = (j == 0) || (j == qt) || (j == qt - 1);
        const float key = forced ? 1e4f : ((j <= qt) ? score : -1.f);
        const unsigned u = key < 0.f ? 0u : (__builtin_bit_cast(unsigned, key) + 1u);
        unsigned thr = 0u;
#pragma unroll
        for (int b = 31; b >= 0; --b) { const unsigned cand = thr | (1u << b); thr = (__popcll(__ballot(u >= cand)) >= 16) ? cand : thr; }
        const unsigned long long gt = __ballot(u > thr), eq = __ballot(u == thr);
        const int need = 16 - (int)__popcll(gt);
        const bool sel = (u > thr) || (u == thr && (int)__popcll(eq & ((1ull << j) - 1ull)) < need);
        const unsigned long long msk = __ballot(sel);
        if (lane == 0) selm[8 * w + k] = msk;
        myu |= msk;
    }
    if (lane == 0) unim[w] = myu;
    __syncthreads();
    at_finish<0>(F, sigmoidf_(gt[0]), l_c, O, slab);
    unsigned long long uni = 0ull;
#pragma unroll
    for (int k = 0; k < 8; ++k) uni |= unim[k];
    const unsigned long long mysel = selm[8 * w + tl];
    m_run = -1e30f; l_run = 0.f;
    { const bf16* KS = Z + (size_t)b * SEQ * ZW + ZC_KS + g * 64; const bf16* VS = Z + (size_t)b * SEQ * ZW + ZC_VS + g * 64;
      unsigned long long rem = uni & ((qt >= 63) ? ~0ull : ((1ull << (qt + 1)) - 1ull));
      int j = __builtin_ctzll(rem); rem &= rem - 1ull;
      at_load(F, KS + (size_t)j * 64 * ZW, ZW, VS + (size_t)j * 64 * ZW, ZW, kw, vw);
      for (;;) {
          at_commit<true>(F, kw, vw, nb);
          const bool more = rem != 0ull; int jn = 0;
          if (more) { jn = __builtin_ctzll(rem); rem &= rem - 1ull; at_load(F, KS + (size_t)jn * 64 * ZW, ZW, VS + (size_t)jn * 64 * ZW, ZW, kw, vw); }
          const bool mine = ((mysel >> j) & 1ull) != 0ull;
          if (__ballot(mine) != 0ull) {
              const int path = (j * 64 + 63 + 790 <= t0) ? 1 : ((j < qt) ? 2 : 0);
#pragma unroll
              for (int kt = 0; kt < 2; ++kt) { at_scores<1>(F, qf, j * 64, t, hd, mine, path, nb, kt, sc); at_accum(F, sc, m_run, l_run, O, nb, kt); }
          }
          if (!more) break;
          j = jn;
      } }
    at_finish<1>(F, sigmoidf_(gt[1]), l_run, O, slab);
    m_run = -1e30f; l_run = 0.f;
    { const bf16* KW = Z + (size_t)b * SEQ * ZW + ZC_KW + g * 64; const bf16* VW = Z + (size_t)b * SEQ * ZW + ZC_VW + g * 64;
      const int j0 = (qt >= 8 ? qt - 8 : 0);
      at_load(F, KW + (size_t)j0 * 64 * ZW, ZW, VW + (size_t)j0 * 64 * ZW, ZW, kw, vw);
      for (int j = j0; j <= qt; ++j) {
          at_commit<true>(F, kw, vw, nb);
          if (j < qt) at_load(F, KW + (size_t)(j + 1) * 64 * ZW, ZW, VW + (size_t)(j + 1) * 64 * ZW, ZW, kw, vw);
          const int path = (j < qt && j + 7 >= qt) ? 2 : 0;
#pragma unroll
          for (int kt = 0; kt < 2; ++kt) { at_scores<2>(F, qf, j * 64, t, hd, true, path, nb, kt, sc); at_accum(F, sc, m_run, l_run, O, nb, kt); }
      } }
    at_finish<2>(F, sigmoidf_(gt[2]), l_run, O, slab);
    bf16* yo = (bf16*)(ws + WS_YRW) + mrow * D + CW + (g * 4 + hd) * 64;
#pragma unroll
    for (int dt = 0; dt < 2; ++dt)
#pragma unroll
        for (int rg = 0; rg < 4; ++rg) { v2u o; o.x = pk2(O[dt][4 * rg], O[dt][4 * rg + 1]); o.y = pk2(O[dt][4 * rg + 2], O[dt][4 * rg + 3]); *(v2u*)(yo + 32 * dt + 8 * rg + 4 * h) = o; }
}
__device__ __forceinline__ void attn_phase(Frame& F, int l, int qbase = CW_Q) {
    LAS int* qslot = (LAS int*)(F.lds + XBASE + 1536);
    for (;;) {
        __syncthreads();
        if (F.tid == 0) *qslot = (int)__hip_atomic_fetch_add((unsigned*)(F.ctl + qbase + l * 64), 1u, RLX_AGENT);
        __syncthreads();
        const int u = *qslot;
        if (u >= 512) break;
        const int bg = u & 7, qt = 63 - (u >> 3);
        F.tid = tid_l(); F.lane = F.tid & 63; F.wave = __builtin_amdgcn_readfirstlane(F.tid >> 6);
        attn_unit(F, bg >> 1, bg & 1, qt);
    }
    __syncthreads();
}


struct Args { const float* in[34]; float* out; unsigned char* ws; };
__device__ __forceinline__ int moe_table(Frame& F, int l, LAS int* tb, LAS int* cn) {
    __syncthreads();
    if (F.tid < NEXP) cn[F.tid] = (int)__hip_atomic_load((unsigned*)(F.ctl + CW_CNT + (l * 32 + F.tid) * 64), RLX_AGENT);
    __syncthreads();
    if (F.tid == 0) { int run = 0; for (int e = 0; e < NEXP; ++e) { tb[e] = run; run += (cn[e] + 255) >> 8; } tb[NEXP] = run; }
    __syncthreads();
    return tb[NEXP];
}
__device__ __forceinline__ int gin_panel(Frame& F) { pg8::StaticOrder S0; S0.init(M, ZW, F.G, bid_l()); pg8::Unit u0; (void)S0.next(0, u0); return __builtin_amdgcn_readfirstlane(u0.pm); }
__device__ __forceinline__ int my_panel(Frame& F) { pg8::StaticOrder S0; S0.init(M, D, F.G, bid_l()); pg8::Unit u0; (void)S0.next(0, u0); return __builtin_amdgcn_readfirstlane(u0.pm); }
__global__ void __launch_bounds__(NT, 2) fwd(Args args) {
    extern __shared__ __attribute__((aligned(16))) unsigned char lds[];
    Frame F;
    F.lds = (LAS unsigned char*)lds;
    F.tid = threadIdx.x; F.lane = F.tid & 63; F.wave = __builtin_amdgcn_readfirstlane(F.tid >> 6);
    F.G = gridDim.x; { const int bx = blockIdx.x; F.bid = bx; F.vcu = (bx % 8) * (F.G / 8) + bx / 8; }
    F.ws = args.ws; F.ctl = (gu32*)(args.ws + WS_CTL);
    unsigned char* ws = args.ws;
    for (int u = F.tid; u < (LDS_BYTES - RING_BYTES) / 4; u += NT) ((LAS unsigned*)(F.lds + RING_BYTES))[u] = 0u;
    __syncthreads();
    if (F.lane == 0) ((LAS int*)(F.lds + WSLOT_OFF))[(unsigned)__builtin_amdgcn_s_getreg((6 << 11) | 4) & 63u] = F.wave;
    if (F.tid == 0) {
#pragma unroll
        for (int k = 0; k < 34; ++k) ((LAS unsigned long long*)(F.lds + TAB_OFF))[k] = (unsigned long long)args.in[k]; }
    __syncthreads();
    (void)xcd_barrier_post((unsigned*)(F.ctl + CW_BAR), (volatile LAS unsigned*)(F.lds + MISC_OFF) + 8);
    LAS int* tb = (LAS int*)(F.lds + XBASE + 1024); LAS int* cn = (LAS int*)(F.lds + XBASE + 1280);
#define GRID_BAR() do { { XcdBarrier b2_; b2_.bar = (unsigned*)((gu32*)(wsp(F) + WS_CTL) + CW_BAR); b2_.x = xb_xcc_id(); b2_.st = (volatile LAS unsigned*)(F.lds + MISC_OFF) + 8; xcd_barrier(b2_); } F.tid = tid_l(); F.lane = F.tid & 63; F.wave = __builtin_amdgcn_readfirstlane(F.tid >> 6); { const int bx = bid_l(); F.bid = bx; F.vcu = (bx % 8) * (F.G / 8) + bx / 8; } } while (0)

#define PANEL_SIGNAL(l_, st_, pm_) do { asm volatile("s_waitcnt vmcnt(0)" ::: "memory"); __syncthreads(); if (F.tid == 0) (void)__hip_atomic_fetch_add((unsigned*)(F.ctl + CW_PANEL + (((l_) * 4 + (st_)) * 64 + (pm_)) * 64), 1u, RLX_AGENT); } while (0)
#define PANEL_WAIT(l_, st_, pm_) do { if (F.tid == 0) { unsigned* p_ = (unsigned*)(F.ctl + CW_PANEL + (((l_) * 4 + (st_)) * 64 + (pm_)) * 64); unsigned sp_ = 0u; \
            while (xb_ld(p_) < 4u) { __builtin_amdgcn_s_sleep(1); if (++sp_ > XB_SPIN_CAP) break; } \
            __builtin_amdgcn_fence(__ATOMIC_ACQUIRE, "agent"); asm volatile("s_waitcnt vmcnt(0)" ::: "memory"); } \
        __syncthreads(); F.tid = tid_l(); F.lane = F.tid & 63; F.wave = __builtin_amdgcn_readfirstlane(F.tid >> 6); { const int bx = bid_l(); F.bid = bx; F.vcu = (bx % 8) * (F.G / 8) + bx / 8; } } while (0)

#define PANEL_WAIT4(l_, st_, a_, b_, c_, d_) do { if (F.tid == 0) { const int pl_[4] = {(a_), (b_), (c_), (d_)}; \
            _Pragma("unroll") for (int i_ = 0; i_ < 4; ++i_) { unsigned* p_ = (unsigned*)(F.ctl + CW_PANEL + (((l_) * 4 + (st_)) * 64 + pl_[i_]) * 64); unsigned sp_ = 0u; \
                while (xb_ld(p_) < 4u) { __builtin_amdgcn_s_sleep(1); if (++sp_ > XB_SPIN_CAP) break; } } \
            __builtin_amdgcn_fence(__ATOMIC_ACQUIRE, "agent"); asm volatile("s_waitcnt vmcnt(0)" ::: "memory"); } \
        __syncthreads(); F.tid = tid_l(); F.lane = F.tid & 63; F.wave = __builtin_amdgcn_readfirstlane(F.tid >> 6); { const int bx = bid_l(); F.bid = bx; F.vcu = (bx % 8) * (F.G / 8) + bx / 8; } } while (0)

#define QUAD_WORD(l_, q_) (CW_PANEL + 65536 + ((l_) * 64 + (q_)) * 64)
#define MOE1_DONE_WORD(l_) (CW_PANEL + 65536 + (4 * 64 + (l_)) * 64)
#define CTR_WAIT(word_, need_, acq_) do { if (F.tid == 0) { unsigned* p_ = (unsigned*)(F.ctl + (word_)); unsigned sp_ = 0u; \
            while (xb_ld(p_) < (unsigned)(need_)) { __builtin_amdgcn_s_sleep(1); if (++sp_ > XB_SPIN_CAP) break; } \
            if (acq_) { __builtin_amdgcn_fence(__ATOMIC_ACQUIRE, "agent"); asm volatile("s_waitcnt vmcnt(0)" ::: "memory"); } } \
        __syncthreads(); F.tid = tid_l(); F.lane = F.tid & 63; F.wave = __builtin_amdgcn_readfirstlane(F.tid >> 6); { const int bx = bid_l(); F.bid = bx; F.vcu = (bx % 8) * (F.G / 8) + bx / 8; } } while (0)

    F.tid = tid_l(); F.lane = F.tid & 63; F.wave = __builtin_amdgcn_readfirstlane(F.tid >> 6);
    lut_phase(F);
    wsmall_phase(F);
    ln_phase<0>(F, 0, nullptr);
    conv_phase<1>(F, 0, 0);
    conv_small(F, 0);
    GRID_BAR();
    int prev_total = 0;
    for (int l = 0; l < DEPTH; ++l) {
        F.tid = tid_l(); F.lane = F.tid & 63; F.wave = __builtin_amdgcn_readfirstlane(F.tid >> 6);
        { unsigned char* ws = wsp(F); float* S0 = (float*)(ws + WS_S); (void)S0; pg8::Gemm g{(const bf16*)(ws + WS_XB), (const bf16*)(ws + WS_WIN), M, ZW, D}; pg8::StaticOrder S; S.init(M, ZW, F.G, bid_l());
          EpiBf16Store E{(bf16*)(ws + WS_Z), ZW, (bf16*)(ws + WS_CMP), (bf16*)(ws + WS_LOR)};
          pg8::gemm_phase<EpiBf16Store, pg8::StaticOrder, false>(F.lds, g, S, E); }
        PANEL_SIGNAL(l, 2, gin_panel(F));
        { const int bx = bid_l(), own = bx >> 2, prv = ((bx & 3) == 0 && (bx & 63) != 0) ? own - 1 : own, c0 = (bx >> 6) * 16 + ((bx >> 1) & 15), c1 = ((bx >> 1) & 15) < 15 ? c0 + 1 : c0;
          PANEL_WAIT4(l, 2, own, prv, c0, c1); }
        prep_unit(F, l, F.bid);
        compress_unit(F, F.bid);
        asm volatile("s_waitcnt vmcnt(0)" ::: "memory"); __syncthreads();
        chunk_prep(F, l, inp(F, 4) + (size_t)l * CW, inp(F, 6) + (size_t)l * CW, inp(F, 10) + (size_t)l * CW);
        GRID_BAR();
        chunk_scan(F, l);
        if (F.bid >= 32 && F.bid < 64) { if (l == 0) conv_phase<2>(F, 0, 0); else conv_phase<3>(F, l, prev_total); __syncthreads(); }
        attn_phase(F, l);
        GRID_BAR();
        { unsigned char* ws = wsp(F); pg8::Gemm g{(const bf16*)(ws + WS_YRW), (const bf16*)(ws + WS_WUPR), M, D, D}; pg8::StaticOrder S; S.init(M, D, F.G, bid_l());
          EpiUpM E{(const bf16*)(ws + WS_Z), (bf16*)(ws + WS_MERGED)};
          pg8::gemm_phase<EpiUpM, pg8::StaticOrder, false>(F.lds, g, S, E); }
        PANEL_SIGNAL(l, 0, my_panel(F));
        { unsigned char* ws = wsp(F); float* S0 = (float*)(ws + WS_S); (void)S0; pg8::Gemm g{(const bf16*)(ws + WS_MERGED), (const bf16*)(ws + WS_WOUT), M, D, D}; pg8::StaticOrder S; S.init(M, D, F.G, bid_l());
          EpiOut E{(const bf16*)(ws + WS_XB), (bf16*)(ws + WS_S + 64 * MiB)};
          auto pre = [&]() { PANEL_WAIT(l, 0, my_panel(F)); };
          pg8::gemm_phase<EpiOut, pg8::StaticOrder, false>(F.lds, g, S, E, pre); }
        PANEL_SIGNAL(l, 1, my_panel(F));
        PANEL_WAIT(l, 1, F.bid >> 2);
        ln_phase<1>(F, l, nullptr);
        if (l + 1 < DEPTH) conv_small(F, l + 1);
        GRID_BAR();
        const int total = moe_table(F, l, tb, cn);
        { unsigned char* ws = wsp(F); float* S0 = (float*)(ws + WS_S); (void)S0; pg8::Gemm g{(const bf16*)(ws + WS_XB), (const bf16*)(ws + WS_W13), M, D, D};
          MoeOrder S{tb, cn, (const unsigned*)(ws + WS_LISTS), F.G, F.vcu, total, (size_t)1024 * 1024 * 2};
          EpiMoe1 E{(bf16*)(ws + WS_S + 128 * MiB)};
          pg8::gemm_phase<EpiMoe1, MoeOrder, true>(F.lds, g, S, E); }
        __syncthreads(); if (F.tid == 0) { (void)__hip_atomic_fetch_add((unsigned*)(F.ctl + QUAD_WORD(l, F.vcu >> 2)), 1u, RLX_AGENT); (void)__hip_atomic_fetch_add((unsigned*)(F.ctl + MOE1_DONE_WORD(l)), 1u, RLX_AGENT); }
        if (l + 1 < DEPTH) conv_tail(F, l + 1, total, 0);
        __syncthreads();
        { unsigned char* ws = wsp(F); float* S0 = (float*)(ws + WS_S); (void)S0; pg8::Gemm g{(const bf16*)(ws + WS_S + 128 * MiB), (const bf16*)(ws + ws_w2(l)), total * 256, D, DEXP};
          MoeOrder S{tb, cn, (const unsigned*)(ws + WS_LISTS), F.G, F.vcu, total, (size_t)1024 * 512 * 2};
          EpiMoe2 E{(bf16*)(ws + WS_YS), (const unsigned*)(ws + WS_LISTS), (const float*)(ws + WS_SLOTW)};
          auto pre = [&]() { CTR_WAIT(QUAD_WORD(l, F.vcu >> 2), 4, true); };
          pg8::gemm_phase<EpiMoe2, MoeOrder, false>(F.lds, g, S, E, pre); }
        if (l + 1 < DEPTH) { CTR_WAIT(MOE1_DONE_WORD(l), 256, false); conv_tail(F, l + 1, total, 1); }
        GRID_BAR();
        ln_phase<2>(F, l, l == DEPTH - 1 ? (float*)(GAS float*)args.out : nullptr);
        if (l + 1 < DEPTH) PANEL_SIGNAL(l, 3, F.bid >> 2);
        if (l + 1 < DEPTH) conv_phase<0>(F, l + 1, total);
        prev_total = total;
        if (l + 1 < DEPTH) {
            const int rem_ = (total * 4) & 255;
            if (rem_ != 0 && (256 - rem_) * 64 >= CV_CAT0) PANEL_WAIT(l, 3, gin_panel(F)); else GRID_BAR();
        }
    }
#undef GRID_BAR
}

extern "C" void kernel_launch(void* const* d_in, const int* in_sizes, int n_in, void* d_out, int out_size, void* d_ws, size_t ws_size, hipStream_t stream) {
    static int grid = 0;
    if (grid == 0) {
        if (n_in != 34 || in_sizes[0] != M * D || out_size != M * D || ws_size < WS_END) { fprintf(stderr, "kernel_launch: unexpected problem: n_in %d in0 %d out %d ws %zu (need %zu)\n", n_in, n_in > 0 ? in_sizes[0] : -1, out_size, ws_size, (size_t)WS_END); grid = -1; return; }
        int dev = 0, cus = 0, per_cu = 0;
        if (hipGetDevice(&dev) != hipSuccess || hipDeviceGetAttribute(&cus, hipDeviceAttributeMultiprocessorCount, dev) != hipSuccess) { grid = -1; return; }
        if (hipFuncSetAttribute((const void*)fwd, hipFuncAttributeMaxDynamicSharedMemorySize, LDS_BYTES) != hipSuccess) { fprintf(stderr, "kernel_launch: hipFuncSetAttribute failed\n"); grid = -1; return; }
        if (hipOccupancyMaxActiveBlocksPerMultiprocessor(&per_cu, (const void*)fwd, NT, LDS_BYTES) != hipSuccess || per_cu < 1) fprintf(stderr, "kernel_launch: occupancy query reports %d\n", per_cu);
        (void)hipGetLastError();
        if (cus < 256) { fprintf(stderr, "kernel_launch: %d CUs < 256\n", cus); grid = -1; return; }
        grid = 256;
    }
    if (grid < 0) return;
    if (hipMemsetAsync((char*)d_ws + WS_CTL, 0, CTL_ZERO_BYTES, stream) != hipSuccess) return;
    Args a{};
    for (int i = 0; i < 34; ++i) a.in[i] = (const float*)d_in[i];
    a.out = (float*)d_out; a.ws = (unsigned char*)d_ws;
    hipLaunchKernelGGL(fwd, dim3(grid), dim3(NT), LDS_BYTES, stream, a);
}
```

```cpp
#include <hip/hip_runtime.h>
#include <cstdio>
#include <cstdint>

constexpr int WSLOT_OFF = 135168 + 1600;
__device__ __forceinline__ int tid_l() {
    const unsigned slot = (unsigned)__builtin_amdgcn_s_getreg((6 << 11) | 4) & 63u;
    extern __shared__ __attribute__((aligned(16))) unsigned char lds_all[];
    int wv = ((const __attribute__((address_space(3))) int*)((__attribute__((address_space(3))) unsigned char*)lds_all + WSLOT_OFF))[slot];
    wv = __builtin_amdgcn_readfirstlane(wv);
    int ln; asm volatile("v_mbcnt_lo_u32_b32 %0, -1, 0\n\tv_mbcnt_hi_u32_b32 %0, -1, %0" : "=v"(ln));
    int t = wv * 64 + ln;
    asm volatile("" : "+v"(t)); return t;
}
__device__ __forceinline__ int bid_l() { int b = blockIdx.x; asm volatile("" : "+s"(b)); return b; }
namespace pg8 {
#define PG8_LAS __attribute__((address_space(3)))
typedef unsigned short bf16_t;
typedef short bf16x8 __attribute__((ext_vector_type(8)));
typedef float f32x4 __attribute__((ext_vector_type(4)));
typedef unsigned u32x4 __attribute__((ext_vector_type(4)));
typedef unsigned u32x2 __attribute__((ext_vector_type(2)));
constexpr int BM = 256, BK = 64, HALF = 128, HTB = HALF * BK * 2  , STAGE_BYTES = 8 * HTB, NXCD = 8, WGM = 8;

__host__ __device__ __forceinline__ int lds_byte(int r, int c) { const int st = (r >> 4) * 2 + (c >> 5), rr = r & 15, cc = c & 31, ob = rr * 64 + cc * 2; return st * 1024 + (ob ^ (((ob >> 9) & 1) << 5)); }
__host__ __device__ __forceinline__ void stage_rc(int b, int& R, int& C) { const int st = b / 1024, sb = b % 1024, swz = sb ^ (((sb >> 9) & 1) << 5); R = (st >> 1) * 16 + swz / 64; C = (st & 1) * 32 + (swz % 64) / 2; }
__host__ __device__ __forceinline__ int perm32(int rho) { const int n = rho >> 4, i = rho & 15; return 8 * (i >> 2) + 4 * n + (i & 3); }

struct Unit { int pm, pn, e, rows, mt; };
struct Gemm { const bf16_t* A; const bf16_t* Bt; int M, N, K; };

struct StaticOrder {
    int nM, nN, nwg, G, c;
    __host__ __device__ void init(int M, int N, int G_, int c_) { nM = M / BM; nN = N / BM; nwg = nM * nN; G = G_; c = c_; }
    __host__ __device__ bool next(int i, Unit& u) const {
        const long L = (long)i * G + c; if (L >= nwg) return false;
        int wgid = (int)L; { const int q = nwg / NXCD, r = nwg % NXCD, xcd = wgid % NXCD, off = wgid / NXCD; wgid = (xcd < r ? xcd * (q + 1) : r * (q + 1) + (xcd - r) * q) + off; }
        const int nig = WGM * nN, gid = wgid / nig, fm = gid * WGM, gsz = (nM - fm) < WGM ? (nM - fm) : WGM;
        u.pm = fm + ((wgid % nig) % gsz); u.pn = (wgid % nig) / gsz; u.e = 0; u.rows = 256; u.mt = 0; return true;
    }
    __device__ __forceinline__ const char* b_base(const Gemm& g, const Unit& u, size_t tstep) const { return (const char*)g.Bt + (size_t)u.pn * tstep; }
    __device__ __forceinline__ int arow(const Unit& u, int r) const { return u.pm * BM + r; }
};

__device__ __forceinline__ unsigned cvt_pk_bf16(float lo, float hi) { unsigned r; asm volatile("v_cvt_pk_bf16_f32 %0, %1, %2" : "=v"(r) : "v"(lo), "v"(hi)); return r; }

struct NoPre { __device__ __forceinline__ void operator()() const {} };
template <class Epi, class Sched, bool GATHER = false, class Pre = NoPre>
__device__ __forceinline__ void gemm_phase(PG8_LAS unsigned char* lds, const Gemm g, const Sched& S, const Epi& E, const Pre& pre = Pre()) {
    const int tid = tid_l(), wid = __builtin_amdgcn_readfirstlane(tid >> 6), lane = tid & 63, wr = wid >> 2, wc = wid & 3, fr = lane & 15, fq = lane >> 4;
    const int K = g.K, nt = K / BK;
    unsigned voffA[2], voffB[2]; int stR[2], stC[2];
#pragma unroll
    for (int i = 0; i < 2; ++i) { int R, C; stage_rc(tid * 16 + i * 8192, R, C); const int Rb = Epi::PERM ? ((R & ~31) + perm32(R & 31)) : R; stR[i] = R; stC[i] = C;
        voffA[i] = (unsigned)(R * K + C) * 2u; voffB[i] = (unsigned)(Rb * K + C) * 2u; }
    const size_t kstep = (size_t)(BK * 2);
    const size_t hstep = (size_t)HALF * K * 2;
    const size_t tstep = 2 * hstep;
    const unsigned ldsw = (unsigned)wid * 1024u;
    const int aoff = lds_byte(wr * 64 + fr, fq * 8), boff = lds_byte(wc * 32 + fr, fq * 8);
#define PG8_SA(b, h) (((b) * 2 + (h)) * HTB)
#define PG8_SB(b, h) ((4 + (b) * 2 + (h)) * HTB)
#define PG8_STAGE(bufoff, gbase, voff) do { _Pragma("unroll") for (int _i = 0; _i < 2; ++_i) \
        __builtin_amdgcn_global_load_lds((const unsigned*)((const char*)(gbase) + (voff)[_i]), (PG8_LAS unsigned*)(lds + (bufoff) + ldsw + _i * 8192), 16, 0, 0); } while (0)
#define PG8_STAGE_A(bufoff, p, kb, h, nx) do { if constexpr (GATHER) { unsigned _vo[2]; _vo[0] = (nx) ? goN[h][0] : goC[h][0]; _vo[1] = (nx) ? goN[h][1] : goC[h][1]; PG8_STAGE(bufoff, (const char*)g.A + (kb), _vo); } \
        else { PG8_STAGE(bufoff, (p) + (h) * hstep, voffA); } } while (0)
#define PG8_LDA(dst, b, h) do { _Pragma("unroll") for (int m = 0; m < 4; ++m) _Pragma("unroll") for (int k = 0; k < 2; ++k) dst[m][k] = *(const PG8_LAS bf16x8*)(lds + PG8_SA(b, h) + aoff + m * 2048 + k * 1024); } while (0)
#define PG8_LDB(dst, b, h) do { _Pragma("unroll") for (int n = 0; n < 2; ++n) _Pragma("unroll") for (int k = 0; k < 2; ++k) dst[n][k] = *(const PG8_LAS bf16x8*)(lds + PG8_SB(b, h) + boff + n * 2048 + k * 1024); } while (0)
#define PG8_MMA(ai, bj, At, Bt) do { __builtin_amdgcn_s_setprio(1); _Pragma("unroll") for (int m = 0; m < 4; ++m) _Pragma("unroll") for (int n = 0; n < 2; ++n) _Pragma("unroll") for (int k = 0; k < 2; ++k) \
        acc[ai][bj][m][n] = __builtin_amdgcn_mfma_f32_16x16x32_bf16(Bt[n][k], At[m][k], acc[ai][bj][m][n], 0, 0, 0); __builtin_amdgcn_s_setprio(0); } while (0)
#define PG8_WAIT_V(n) asm volatile("s_waitcnt vmcnt(" #n ")" ::: "memory")
#define PG8_WAIT_L(n) asm volatile("s_waitcnt lgkmcnt(" #n ")" ::: "memory")
#define PG8_BAR __builtin_amdgcn_s_barrier()
#define PG8_SCHED __builtin_amdgcn_sched_barrier(0)
    Unit cur, nxt; int ui = 0;
    if (!S.next(0, cur)) return;
    f32x4 acc[2][2][4][2];
#pragma unroll
    for (int a = 0; a < 2; ++a)
#pragma unroll
        for (int b = 0; b < 2; ++b)
#pragma unroll
            for (int m = 0; m < 4; ++m)
#pragma unroll
                for (int n = 0; n < 2; ++n) acc[a][b][m][n] = (f32x4){0.f, 0.f, 0.f, 0.f};
    bf16x8 At[4][2], B0[2][2], B1[2][2];
    unsigned goC[2][2], goN[2][2];
    if constexpr (GATHER) {
#pragma unroll
        for (int h = 0; h < 2; ++h)
#pragma unroll
            for (int i = 0; i < 2; ++i) { goC[h][i] = ((unsigned)S.arow(cur, h * HALF + stR[i]) * (unsigned)K + (unsigned)stC[i]) * 2u; goN[h][i] = goC[h][i]; }
    }
    const char* cA = (const char*)g.A + (size_t)cur.pm * tstep; const char* cB = S.b_base(g, cur, tstep);
    PG8_STAGE(PG8_SB(0, 0), cB, voffB); PG8_STAGE(PG8_SB(0, 1), cB + hstep, voffB); pre(); PG8_STAGE_A(PG8_SA(0, 0), cA, 0, 0, false); PG8_STAGE_A(PG8_SA(0, 1), cA, 0, 1, false);
    if (wr == 1) PG8_BAR;
    PG8_WAIT_V(2); PG8_BAR;
    PG8_STAGE(PG8_SB(1, 0), cB + kstep, voffB); PG8_STAGE_A(PG8_SA(1, 0), cA + kstep, kstep, 0, false); PG8_STAGE(PG8_SB(1, 1), cB + hstep + kstep, voffB);
    PG8_WAIT_V(6); PG8_BAR;
    for (;;) {
        const bool has_next = S.next(ui + 1, nxt);
        const char* nA = has_next ? (const char*)g.A + (size_t)nxt.pm * tstep : cA; const char* nB = has_next ? S.b_base(g, nxt, tstep) : cB;
        if constexpr (GATHER) {
#pragma unroll
            for (int h = 0; h < 2; ++h)
#pragma unroll
                for (int i = 0; i < 2; ++i) goN[h][i] = has_next ? ((unsigned)S.arow(nxt, h * HALF + stR[i]) * (unsigned)K + (unsigned)stC[i]) * 2u : goC[h][i];
        }
_Pragma("nounroll")
        for (int t = 0; t < nt; t += 2) {
            if constexpr (Epi::HAS_MID) { if (t == nt / 2) {
                typedef unsigned u32x4_ __attribute__((ext_vector_type(4)));
                u32x4_ gr0[2][2], gn0[2][2], gr1[2][2], gn1[2][2];
                E.mid_load(cur, wr, wc, fr, fq, 0, 0, gr0, gn0);
#pragma unroll
                for (int st = 0; st < 4; ++st) { const int a = st >> 1, mp = st & 1; f32x4 f8[2][2][2];
                    if (st + 1 < 4) { if (st & 1) E.mid_load(cur, wr, wc, fr, fq, (st + 1) >> 1, (st + 1) & 1, gr0, gn0); else E.mid_load(cur, wr, wc, fr, fq, (st + 1) >> 1, (st + 1) & 1, gr1, gn1); }
                    __builtin_amdgcn_sched_barrier(0);
                    if (st & 1) E.mid_fac(gr1, gn1, f8); else E.mid_fac(gr0, gn0, f8);
#pragma unroll
                    for (int mm = 0; mm < 2; ++mm)
#pragma unroll
                        for (int b = 0; b < 2; ++b)
#pragma unroll
                            for (int n = 0; n < 2; ++n) acc[a][b][2 * mp + mm][n] = acc[a][b][2 * mp + mm][n] * f8[mm][b][n];
                    asm volatile("" ::: "memory"); } } }
            const bool last = (t == nt - 2);
            const char* a1 = cA + (size_t)(t + 1) * kstep; const size_t k1 = (size_t)(t + 1) * kstep;
            const char* a2 = last ? nA : cA + (size_t)(t + 2) * kstep; const char* b2 = last ? nB : cB + (size_t)(t + 2) * kstep; const size_t k2 = last ? 0 : (size_t)(t + 2) * kstep;
            const char* a3 = a2 + kstep; const char* b3 = b2 + kstep; const size_t k3 = k2 + kstep;
            PG8_LDB(B0, 0, 0); PG8_LDB(B1, 0, 1); PG8_SCHED; PG8_LDA(At, 0, 0); PG8_STAGE_A(PG8_SA(1, 1), a1, k1, 1, false);
            PG8_WAIT_V(8); PG8_WAIT_L(0); PG8_BAR; PG8_MMA(0, 0, At, B0); PG8_MMA(0, 1, At, B1); PG8_BAR; PG8_SCHED;
            PG8_LDA(At, 0, 1); PG8_STAGE(PG8_SB(0, 0), b2, voffB); PG8_STAGE(PG8_SB(0, 1), b2 + hstep, voffB); PG8_STAGE_A(PG8_SA(0, 0), a2, k2, 0, last);
            PG8_WAIT_V(8); PG8_WAIT_L(0); PG8_BAR; PG8_MMA(1, 0, At, B0); PG8_MMA(1, 1, At, B1); PG8_BAR; PG8_SCHED;
            PG8_LDB(B0, 1, 0); PG8_LDB(B1, 1, 1); PG8_SCHED; PG8_LDA(At, 1, 0); PG8_STAGE_A(PG8_SA(0, 1), a2, k2, 1, last);
            PG8_WAIT_V(8); PG8_WAIT_L(0); PG8_BAR; PG8_MMA(0, 0, At, B0); PG8_MMA(0, 1, At, B1); PG8_BAR; PG8_SCHED;
            PG8_LDA(At, 1, 1); PG8_STAGE(PG8_SB(1, 0), b3, voffB); PG8_STAGE(PG8_SB(1, 1), b3 + hstep, voffB); PG8_STAGE_A(PG8_SA(1, 0), a3, k3, 0, last);
            PG8_WAIT_V(8); PG8_WAIT_L(0); PG8_BAR; PG8_MMA(1, 0, At, B0); PG8_MMA(1, 1, At, B1); PG8_BAR; PG8_SCHED;
        }
        if (wr == 0) PG8_BAR;
        E(acc, cur, wr, wc, fr, fq);
        if (!has_next) break;
#pragma unroll
        for (int a = 0; a < 2; ++a)
#pragma unroll
            for (int b = 0; b < 2; ++b)
#pragma unroll
                for (int m = 0; m < 4; ++m)
#pragma unroll
                    for (int n = 0; n < 2; ++n) acc[a][b][m][n] = (f32x4){0.f, 0.f, 0.f, 0.f};
        cur = nxt; cA = nA; cB = nB; ++ui;
        if constexpr (GATHER) {
#pragma unroll
            for (int h = 0; h < 2; ++h)
#pragma unroll
                for (int i = 0; i < 2; ++i) goC[h][i] = goN[h][i];
        }
        if (wr == 1) PG8_BAR;
    }
    PG8_WAIT_V(0);
    PG8_BAR;
#undef PG8_SA
#undef PG8_SB
#undef PG8_STAGE
#undef PG8_STAGE_A
#undef PG8_LDA
#undef PG8_LDB
#undef PG8_MMA
#undef PG8_WAIT_V
#undef PG8_WAIT_L
#undef PG8_BAR
#undef PG8_SCHED
}
}

constexpr int NWAVES = 8, NT = NWAVES * 64;
constexpr int D = 1024, BATCH = 4, SEQ = 4096, M = BATCH * SEQ, DEPTH = 4;
constexpr int CW = 512;
constexpr int ZW = 5120;
constexpr int INW = 5144;
constexpr int ZC_R = 0, ZC_K = 512, ZC_V = 1024, ZC_WL = 1536, ZC_AL = 1600, ZC_GL = 1664, ZC_Q = 1792, ZC_KC = 2304, ZC_VC = 2432, ZC_KS = 2560, ZC_VS = 2688, ZC_KW = 2816, ZC_VW = 2944, ZC_GRW = 3072, ZC_GNSA = 4096;
constexpr int NEXP = 32, DEXP = 512;
constexpr int LOR_PN = ZC_WL / 256;
static_assert(ZC_WL % 256 == 0 && ZC_Q == ZC_WL + 256, "LoRA inputs fill one column tile");
constexpr int CMP_PN = ZC_KC / 256;
static_assert(ZC_KC % 256 == 0 && ZC_VC == ZC_KC + 128, "compression inputs fill one column tile");
constexpr float LN_EPS = 1e-5f, GN_EPS = 64e-5f;
constexpr float ALPHA = 1.6817928305074290f;
constexpr int NCMP = 255;

constexpr size_t MiB = 1u << 20;
constexpr size_t WS_CTL = 0, CTL_ZERO_BYTES = 1 * MiB;
constexpr size_t WS_WIN = 2 * MiB, WS_WLORA = 12 * MiB, WS_WUPR = 13 * MiB, WS_WUPN = 14 * MiB, WS_WOUT = 15 * MiB;
constexpr size_t WS_WC1K = 17 * MiB, WS_WC1V = 17 * MiB + 512 * 1024, WS_WC2K = 18 * MiB, WS_WC2V = 18 * MiB + 64 * 1024, WS_PEB = 18 * MiB + 128 * 1024, WS_LUT = 18 * MiB + 192 * 1024;
constexpr size_t WS_WGT = 18 * MiB + 256 * 1024, WS_WRH = 18 * MiB + 512 * 1024, WS_WRL = 18 * MiB + 896 * 1024;
constexpr size_t WS_W13 = 20 * MiB, WS_W2 = 84 * MiB, WS_W2B = 604 * MiB;
__device__ __forceinline__ size_t ws_w2(int l) { return (l & 1) ? WS_W2B : WS_W2; }
constexpr size_t WS_Z = 116 * MiB;
constexpr size_t WS_S = 276 * MiB;
constexpr size_t WS_Y = 500 * MiB, WS_AP = 532 * MiB, WS_YRW = 540 * MiB, WS_YNSA = 556 * MiB, WS_MERGED = 572 * MiB;
constexpr size_t WS_X1 = 604 * MiB, WS_XB = 668 * MiB, WS_X2 = 700 * MiB, WS_CMP = 700 * MiB, WS_LOR = 636 * MiB, WS_YS = 708 * MiB,     WS_VST = 764 * MiB, WS_VWT = 768 * MiB, WS_KC = 772 * MiB, WS_VCT = 772 * MiB + 256 * 1024;
constexpr size_t WS_GATES = 773 * MiB, WS_LISTS = 775 * MiB, WS_SLOTW = 777 * MiB, WS_WLIST = 778 * MiB  , WS_CHK = 780 * MiB, WS_OACC = 872 * MiB, WS_END = 888 * MiB;
constexpr size_t SARR = (size_t)M * CW * 4;
constexpr int CW_TMO = 0;
constexpr int CW_BAR = 4096;
constexpr int CW_Q = 24576;
constexpr int CW_CV = 28672;
constexpr int CW_PANEL = 65536;
constexpr int CW_CNT = 16384;
constexpr int RING_BYTES = 131072;
constexpr int XBASE = 135168;
constexpr int MISC_OFF = XBASE + 320;
constexpr int LDS_BYTES = 147456;

#define GAS __attribute__((address_space(1)))
#define LAS __attribute__((address_space(3)))
#define GAS __attribute__((address_space(1)))
typedef unsigned short bf16;
typedef unsigned v4u __attribute__((ext_vector_type(4)));
typedef unsigned v2u __attribute__((ext_vector_type(2)));
typedef float f32x4 __attribute__((ext_vector_type(4)));
typedef float f32x16 __attribute__((ext_vector_type(16)));
typedef short bf16x8 __attribute__((ext_vector_type(8)));
typedef short s16x4 __attribute__((ext_vector_type(4)));
typedef GAS unsigned gu32;
#define RLX_AGENT __ATOMIC_RELAXED, __HIP_MEMORY_SCOPE_AGENT
#define LDS_WAIT() asm volatile("s_waitcnt lgkmcnt(0)" ::: "memory")
#define VM_WAIT() asm volatile("s_waitcnt vmcnt(0)" ::: "memory")
typedef float f32x2_t __attribute__((ext_vector_type(2)));
typedef __bf16 bf16x2_t __attribute__((ext_vector_type(2)));
__device__ __forceinline__ unsigned cvtpk(float lo, float hi) { const f32x2_t v = {lo, hi}; const bf16x2_t b = __builtin_convertvector(v, bf16x2_t); return __builtin_bit_cast(unsigned, b); }
__device__ __forceinline__ unsigned pk2(float lo, float hi) { return cvtpk(lo, hi); }
__device__ __forceinline__ void st_wt(void* p, v4u v) { asm volatile("global_store_dwordx4 %0, %1, off sc1\n\ts_nop 1" :: "v"((GAS void*)p), "v"(v) : "memory"); }
__device__ __forceinline__ void st_wt_nb(void* p, v4u v) { asm volatile("global_store_dwordx4 %0, %1, off sc1\n\ts_nop 1" :: "v"((GAS void*)p), "v"(v)); }

__device__ __forceinline__ unsigned f2bf(float f) { return cvtpk(f, 0.f) & 0xffffu; }
__device__ __forceinline__ float bf2f(unsigned short b) { return __builtin_bit_cast(float, ((unsigned)b) << 16); }
__device__ __forceinline__ float bflo(unsigned w) { return __builtin_bit_cast(float, w << 16); }
__device__ __forceinline__ float bfhi(unsigned w) { return __builtin_bit_cast(float, w & 0xffff0000u); }
__device__ __forceinline__ float sigmoidf_(float x) { return __builtin_amdgcn_rcpf(1.f + __expf(-x)); }

#define XB_TMO      128
#define XB_XCNT(j)  (256  + 64 * (j))
#define XB_XSUB(j)  (1280 + 64 * (j))
#define XB_XGEN(j)  (2304 + 64 * (j))
#define XB_TOP      3328
#define XB_TOPGEN   3392
#define XCD_BAR_WORDS 3456
#define XB_SPIN_CAP (1u << 18)
__device__ __forceinline__ unsigned xb_ld(unsigned* p)              { return __hip_atomic_load(p, __ATOMIC_RELAXED, __HIP_MEMORY_SCOPE_AGENT); }
__device__ __forceinline__ unsigned xb_add(unsigned* p, unsigned v) { return __hip_atomic_fetch_add(p, v, __ATOMIC_RELAXED, __HIP_MEMORY_SCOPE_AGENT); }
__device__ __forceinline__ unsigned xb_xcc_id() { return (unsigned)__builtin_amdgcn_s_getreg((3 << 11) | 20) & 0xFu; }
#define XB_SPIN(cond, bar) do { unsigned _sp = 0; while (cond) { __builtin_amdgcn_s_sleep(1); \
    if ((++_sp & 255u) == 0u) { if (xb_ld(&(bar)[XB_TMO])) break; if (_sp > XB_SPIN_CAP) { atomicAdd(&(bar)[XB_TMO], 1u); break; } } } } while (0)
struct XcdBarrier { unsigned* bar; unsigned x; volatile LAS unsigned* st; };
__device__ __forceinline__ XcdBarrier xcd_barrier_post(unsigned* bar, volatile LAS unsigned* st) {
    XcdBarrier b; b.bar = bar; b.x = xb_xcc_id(); b.st = st;
    if (threadIdx.x == 0) (void)xb_add(&bar[XB_XCNT(b.x)], 1u);
    return b;
}
__device__ __forceinline__ void xcd_barrier_complete(unsigned* bar, unsigned x, unsigned& nloc, unsigned& nx) {
    const unsigned G = gridDim.x * gridDim.y * gridDim.z;
    unsigned sum, cnt, mine, sp = 0u;
    for (;;) {
        sum = 0u; cnt = 0u; mine = 0u;
#pragma unroll
        for (unsigned j = 0; j < 16; ++j) { const unsigned c = xb_ld(&bar[XB_XCNT(j)]); sum += c; cnt += (c > 0u) ? 1u : 0u; mine = (j == x) ? c : mine; }
        if (sum == G) break;
        __builtin_amdgcn_s_sleep(1);
        if ((++sp & 255u) == 0u) { if (xb_ld(&bar[XB_TMO])) break; if (sp > XB_SPIN_CAP) { atomicAdd(&bar[XB_TMO], 1u); break; } }
    }
    nloc = mine > 0u ? mine : 1u; nx = cnt > 0u ? cnt : 1u;
}
__device__ __forceinline__ void xcd_barrier(const XcdBarrier& b) {
    asm volatile("s_waitcnt vmcnt(0)" ::: "memory");
    __syncthreads();
    if (threadIdx.x == 0) {
        unsigned* bar = b.bar;
        __builtin_amdgcn_s_waitcnt(0);
        unsigned nloc = b.st[0], nx = b.st[1];
        if (nloc == 0u) { xcd_barrier_complete(bar, b.x, nloc, nx); b.st[0] = nloc; b.st[1] = nx; }
        const unsigned old = xb_add(&bar[XB_XSUB(b.x)], 1u);
        const unsigned gen = old / nloc;
        if (old + 1u == (gen + 1u) * nloc) {
            __builtin_amdgcn_fence(__ATOMIC_RELEASE, "agent");
            asm volatile("s_waitcnt vmcnt(0)" ::: "memory");
            const unsigned og = xb_add(&bar[XB_TOP], 1u);
            const unsigned tg = og / nx;
            if (og + 1u == (tg + 1u) * nx) xb_add(&bar[XB_TOPGEN], 1u);
            else XB_SPIN(xb_ld(&bar[XB_TOPGEN]) == tg, bar);
            __builtin_amdgcn_fence(__ATOMIC_ACQUIRE, "agent");
            xb_add(&bar[XB_XGEN(b.x)], 1u);
            asm volatile("s_waitcnt vmcnt(0)" ::: "memory");
        } else {
            XB_SPIN(xb_ld(&bar[XB_XGEN(b.x)]) == gen, bar);
            __builtin_amdgcn_fence(__ATOMIC_ACQUIRE, "agent");
            asm volatile("s_waitcnt vmcnt(0)" ::: "memory");
        }
    }
    __syncthreads();
}

struct Frame {
    LAS unsigned char* lds;
    gu32* ctl;
    unsigned char* ws;
    int tid, lane, wave, G, vcu, bid;
};
template<int CTRL> __device__ __forceinline__ float dpp_mov(float v) { return __builtin_bit_cast(float, __builtin_amdgcn_update_dpp(0, __builtin_bit_cast(int, v), CTRL, 0xF, 0xF, true)); }
__device__ __forceinline__ float sum4(float v)  { v += dpp_mov<0xB1>(v); v += dpp_mov<0x4E>(v); return v; }
__device__ __forceinline__ float sum8(float v)  { v = sum4(v); v += dpp_mov<0x141>(v); return v; }
__device__ __forceinline__ float sum16(float v) { v = sum8(v); v += dpp_mov<0x140>(v); return v; }
__device__ __forceinline__ void pl32_swap(unsigned& a, unsigned& b) { asm volatile("s_nop 1\n\tv_permlane32_swap_b32 %0, %1\n\ts_nop 1" : "+v"(a), "+v"(b)); }
__device__ __forceinline__ float x32_sum(float v) { unsigned a = __builtin_bit_cast(unsigned, v), b = a; pl32_swap(a, b); return __builtin_bit_cast(float, a) + __builtin_bit_cast(float, b); }
__device__ __forceinline__ float x32_max(float v) { unsigned a = __builtin_bit_cast(unsigned, v), b = a; pl32_swap(a, b); return fmaxf(__builtin_bit_cast(float, a), __builtin_bit_cast(float, b)); }
__device__ __forceinline__ float wave_sum(float v) {
    v = sum16(v);
    v += __builtin_bit_cast(float, __builtin_amdgcn_update_dpp(0, __builtin_bit_cast(int, v), 0x142, 0xA, 0xF, false));
    v += __builtin_bit_cast(float, __builtin_amdgcn_update_dpp(0, __builtin_bit_cast(int, v), 0x143, 0xC, 0xF, false));
    return __builtin_bit_cast(float, __builtin_amdgcn_readlane(__builtin_bit_cast(int, v), 63));
}

constexpr int TAB_OFF = XBASE + 2048;
__device__ __forceinline__ const float* inp(const Frame& F, int k) {
    const LAS unsigned* t = (const LAS unsigned*)(F.lds + TAB_OFF) + 2 * k;
    const unsigned lo = (unsigned)__builtin_amdgcn_readfirstlane((int)t[0]), hi = (unsigned)__builtin_amdgcn_readfirstlane((int)t[1]);
    return (const float*)(GAS const float*)(((unsigned long long)hi << 32) | lo);
}
__device__ __forceinline__ unsigned char* wsp(const Frame& F) { GAS unsigned char* p = (GAS unsigned char*)F.ws; asm volatile("" : "+s"(p)); return (unsigned char*)p; }
__device__ __forceinline__ f32x4 ld_bf4(const bf16* p) { const v2u w = *(const v2u*)p; return (f32x4){bflo(w.x), bfhi(w.x), bflo(w.y), bfhi(w.y)}; }

struct TrItem { const float* src; bf16* dst; int ld, K; };
__device__ __forceinline__ TrItem tr_mk(const float* W, int ld, int scol0, bf16* WT, int K, int drow0, int k0) { return TrItem{W + (size_t)k0 * ld + scol0, WT + (size_t)drow0 * K + k0, ld, K}; }
__device__ __forceinline__ void tr_load(const TrItem& d, int lane, f32x4 (&w)[8]) {
#pragma unroll
    for (int i = 0; i < 8; ++i) w[i] = *(const f32x4*)(d.src + (size_t)(8 * i + (lane >> 3)) * d.ld + (lane & 7) * 4);
}
__device__ __forceinline__ void tr_store(const TrItem& d, int lane, LAS float* scr, const f32x4 (&w)[8]) {
#pragma unroll
    for (int i = 0; i < 8; ++i) { const int kk = 8 * i + (lane >> 3), c4 = (lane & 7) * 4; scr[kk * 33 + c4] = w[i].x; scr[kk * 33 + c4 + 1] = w[i].y; scr[kk * 33 + c4 + 2] = w[i].z; scr[kk * 33 + c4 + 3] = w[i].w; }
    LDS_WAIT(); asm volatile("" ::: "memory");
    const int c = lane & 7;
#pragma unroll
    for (int j = 0; j < 4; ++j) { const int n = (lane >> 3) + 8 * j; const LAS float* s = scr + (8 * c) * 33 + n;
        v4u o; o.x = pk2(s[0 * 33], s[1 * 33]); o.y = pk2(s[2 * 33], s[3 * 33]); o.z = pk2(s[4 * 33], s[5 * 33]); o.w = pk2(s[6 * 33], s[7 * 33]);
        st_wt(d.dst + (size_t)n * d.K + 8 * c, o); }
    LDS_WAIT(); asm volatile("" ::: "memory");
}
constexpr int CV_I0 = 2560, CV_I1 = 256, CV_I2 = 256, CV_I3 = 512, CV_I4 = 128, CV_I5 = 128, CV_I6 = 4, CV_I7 = 4, CV_I8 = 16384, CV_I9 = 8192;
constexpr int CV_NITEMS = CV_I0 + CV_I1 + CV_I2 + CV_I3 + CV_I4 + CV_I5 + CV_I6 + CV_I7 + CV_I8 + CV_I9;
__device__ __forceinline__ TrItem conv_item(Frame& F, unsigned char* ws, int l, int it) {
    int r = it;
    if (r < CV_I0) { const int kb = r / 160, nb = r % 160, n0 = 32 * nb; return tr_mk(inp(F, 2) + (size_t)l * D * INW, INW, n0 < 3072 ? n0 : n0 + 24, (bf16*)(ws + WS_WIN), D, n0, 64 * kb); } r -= CV_I0;
    if (r < CV_I1) { return tr_mk(inp(F, 20) + (size_t)l * CW * D, D, 32 * (r % 32), (bf16*)(ws + WS_WUPR), D, 32 * (r % 32), 64 * (r / 32)); } r -= CV_I1;
    if (r < CV_I2) { return tr_mk(inp(F, 21) + (size_t)l * CW * D - (size_t)CW * D, D, 32 * (r % 32), (bf16*)(ws + WS_WUPR), D, 32 * (r % 32), 512 + 64 * (r / 32)); } r -= CV_I2;
    if (r < CV_I3) { return tr_mk(inp(F, 22) + (size_t)l * D * D, D, 32 * (r % 32), (bf16*)(ws + WS_WOUT), D, 32 * (r % 32), 64 * (r / 32)); } r -= CV_I3;
    if (r < CV_I4) { return tr_mk(inp(F, 15) + (size_t)l * 2048 * 128, 128, 32 * (r % 4), (bf16*)(ws + WS_WC1K), 2048, 32 * (r % 4), 64 * (r / 4)); } r -= CV_I4;
    if (r < CV_I5) { return tr_mk(inp(F, 18) + (size_t)l * 2048 * 128, 128, 32 * (r % 4), (bf16*)(ws + WS_WC1V), 2048, 32 * (r % 4), 64 * (r / 4)); } r -= CV_I5;
    if (r < CV_I6) { return tr_mk(inp(F, 16) + (size_t)l * 128 * 64, 64, 32 * (r % 2), (bf16*)(ws + WS_WC2K), 128, 32 * (r % 2), 64 * (r / 2)); } r -= CV_I6;
    if (r < CV_I7) { return tr_mk(inp(F, 19) + (size_t)l * 128 * 64, 64, 32 * (r % 2), (bf16*)(ws + WS_WC2V), 128, 32 * (r % 2), 64 * (r / 2)); } r -= CV_I7;
    if (r < CV_I8) { const int e = r / 512, rr = r % 512, mat = rr / 256, q = rr % 256, kb = q / 16, nb = q % 16, pn = nb / 4, cc0 = (nb % 4) * 32;
        return tr_mk(inp(F, mat ? 30 : 29) + ((size_t)l * NEXP + e) * D * DEXP, DEXP, 32 * nb, (bf16*)(ws + WS_W13) + (size_t)e * 1024 * 1024, D, 256 * pn + 128 * mat + cc0, 64 * kb); } r -= CV_I8;
    { const int e = r / 256, q = r % 256, kb = q / 32, nb = q % 32;
        return tr_mk(inp(F, 31) + ((size_t)l * NEXP + e) * DEXP * D, D, 32 * nb, (bf16*)(ws + ws_w2(l)) + (size_t)e * 1024 * 512, DEXP, 32 * nb, 64 * kb); }
}
constexpr int CV_CAT0 = CV_I0 + CV_I1 + CV_I2 + CV_I3 + CV_I4 + CV_I5 + CV_I6 + CV_I7, CV_CAT1 = CV_I8, CV_CAT2 = CV_I9;
static_assert(CV_CAT0 % 8 == 0 && CV_CAT1 % 8 == 0 && CV_CAT2 % 8 == 0, "fill granularity");
__device__ __forceinline__ void conv_fill8(Frame& F, int l, int i0) {
    LAS float* scr = (LAS float*)(F.lds + F.wave * 16384);
    unsigned char* ws = wsp(F); const int lane = F.lane;
    TrItem d0, d1, d2; f32x4 w0[8], w1[8], w2[8];
    d0 = conv_item(F, ws, l, i0); tr_load(d0, lane, w0); d1 = conv_item(F, ws, l, i0 + 1); tr_load(d1, lane, w1);
    d2 = conv_item(F, ws, l, i0 + 2); tr_load(d2, lane, w2); tr_store(d0, lane, scr, w0);
    d0 = conv_item(F, ws, l, i0 + 3); tr_load(d0, lane, w0); tr_store(d1, lane, scr, w1);
    d1 = conv_item(F, ws, l, i0 + 4); tr_load(d1, lane, w1); tr_store(d2, lane, scr, w2);
    d2 = conv_item(F, ws, l, i0 + 5); tr_load(d2, lane, w2); tr_store(d0, lane, scr, w0);
    d0 = conv_item(F, ws, l, i0 + 6); tr_load(d0, lane, w0); tr_store(d1, lane, scr, w1);
    d1 = conv_item(F, ws, l, i0 + 7); tr_load(d1, lane, w1); tr_store(d2, lane, scr, w2);
    tr_store(d0, lane, scr, w0); tr_store(d1, lane, scr, w1);
}
__device__ __forceinline__ void conv_tail(Frame& F, int l, int total, int ph) {
    const int rem = (total * 4) & 255;
    if (rem != 0 && F.vcu >= rem) { const int first = ((F.vcu - rem) * 8 + F.wave) * 8;
        if (ph == 0) { if (first < CV_CAT0) conv_fill8(F, l, first); else if (first < CV_CAT0 + CV_CAT2) conv_fill8(F, l, first + CV_CAT1); }
        else if (first < CV_CAT1) conv_fill8(F, l, CV_CAT0 + first); }
}
template <int MODE> __device__ __forceinline__ void conv_phase(Frame& F, int l, int total) {
    LAS float* scr = (LAS float*)(F.lds + F.wave * 16384);
    unsigned char* ws = wsp(F);
    const int gw = (MODE >= 2 ? (F.bid - 32) : F.vcu) * NWAVES + F.wave, NGW = (MODE >= 2 ? 32 : 256) * NWAVES, lane = F.lane;
    int s0 = 0, s1 = 0, s2 = 0;
    if (MODE == 1) { s1 = CV_CAT1; s2 = CV_CAT2; }
    if (MODE == 2) s0 = CV_CAT0;
    if (MODE == 0 || MODE == 3) { const int rem = (total * 4) & 255, done = rem ? (256 - rem) * 64 : 0; s0 = done < CV_CAT0 ? done : CV_CAT0; s1 = done < CV_CAT1 ? done : CV_CAT1; s2 = done - s0 < CV_CAT2 ? done - s0 : CV_CAT2; }
    if (MODE == 0) s1 = CV_CAT1;
    if (MODE == 3) { s0 = CV_CAT0; s2 = CV_CAT2; }
    const int n0 = CV_CAT0 - s0, n1 = CV_CAT1 - s1, NLEFT = n0 + n1 + CV_CAT2 - s2;
#define CV_MAP(j) ((j) < n0 ? (j) + s0 : ((j) < n0 + n1 ? (j) - n0 + CV_CAT0 + s1 : (j) - n0 - n1 + CV_CAT0 + CV_CAT1 + s2))
    { TrItem d0, d1, d2; f32x4 w0[8], w1[8], w2[8];
      int it = gw;
      if (it < NLEFT) { d0 = conv_item(F, ws, l, CV_MAP(it)); tr_load(d0, lane, w0); }
      if (it + NGW < NLEFT) { d1 = conv_item(F, ws, l, CV_MAP(it + NGW)); tr_load(d1, lane, w1); }
      for (; it < NLEFT; it += 3 * NGW) {
          const int i1 = it + NGW, i2 = it + 2 * NGW, i3 = it + 3 * NGW, i4 = it + 4 * NGW;
          if (i2 < NLEFT) { d2 = conv_item(F, ws, l, CV_MAP(i2)); tr_load(d2, lane, w2); }
          tr_store(d0, lane, scr, w0);
          if (i1 < NLEFT) { if (i3 < NLEFT) { d0 = conv_item(F, ws, l, CV_MAP(i3)); tr_load(d0, lane, w0); } tr_store(d1, lane, scr, w1);
              if (i2 < NLEFT) { if (i4 < NLEFT) { d1 = conv_item(F, ws, l, CV_MAP(i4)); tr_load(d1, lane, w1); } tr_store(d2, lane, scr, w2); } }
      } }
#undef CV_MAP
}
__device__ __forceinline__ void conv_small(Frame& F, int l) {
    unsigned char* ws = wsp(F); const int lane = F.lane;
    { bf16* WLW = (bf16*)(ws + WS_WLORA); bf16* WLA = WLW + 512 * 64; bf16* WLG = WLA + 512 * 64; const float* w2 = inp(F, 5) + (size_t)l * 64 * CW; const float* a2 = inp(F, 7) + (size_t)l * 64 * CW; const float* g2 = inp(F, 8) + (size_t)l * 128 * CW;
      for (int i = F.vcu * NT + F.tid; i < 512 * 256; i += 256 * NT) { const int c = i >> 8, k = i & 255;
          if (k < 64) WLW[c * 64 + k] = (bf16)f2bf(w2[k * CW + c]); else if (k < 128) WLA[c * 64 + (k - 64)] = (bf16)f2bf(a2[(k - 64) * CW + c]); else WLG[c * 128 + (k - 128)] = (bf16)f2bf(g2[(k - 128) * CW + c]); } }
    if (F.wave == 0) { const int task = F.vcu, which = task >> 7, n = task & 127;
        const float* pe = inp(F, which ? 17 : 14) + (size_t)l * 2048; const float* w1 = inp(F, which ? 18 : 15) + (size_t)l * 2048 * 128; float s = 0.f;
        float pv[32], wv[32];
#pragma unroll
        for (int i = 0; i < 32; ++i) { pv[i] = pe[lane + 64 * i]; wv[i] = w1[(size_t)(lane + 64 * i) * 128 + n]; }
#pragma unroll
        for (int i = 0; i < 32; ++i) s += pv[i] * wv[i];
        s = wave_sum(s); if (lane == 0) ((float*)(ws + WS_PEB))[task] = s; }
}

__device__ __forceinline__ void lut_phase(Frame& F) {
    float* lut = (float*)(wsp(F) + WS_LUT); const float* rb = inp(F, 1);
    for (int i = F.vcu * NT + F.tid; i < 8 * 1024; i += 256 * NT) { const int h = i >> 10, n = i & 1023; int bk = n;
        if (n >= 16) bk = 16 + (n >= 21) + (n >= 27) + (n >= 35) + (n >= 46) + (n >= 59) + (n >= 77) + (n >= 99) + (n >= 128) + (n >= 166) + (n >= 216) + (n >= 280) + (n >= 363) + (n >= 470) + (n >= 609) + (n >= 790);
        lut[i] = rb[bk * 8 + h] * 1.4426950408889634f; }
}
__device__ __forceinline__ void wsmall_phase(Frame& F) {
    unsigned char* ws = wsp(F);
    bf16* wgt = (bf16*)(ws + WS_WGT); bf16* wrh = (bf16*)(ws + WS_WRH); bf16* wrl = (bf16*)(ws + WS_WRL);
    const float* win = inp(F, 2); const float* rg = inp(F, 25); const float* re = inp(F, 27);
    for (int i = F.vcu * NT + F.tid; i < DEPTH * 32 * 1024; i += 256 * NT) { const int ln = i >> 15, n = (i >> 10) & 31, k = i & 1023;
        wgt[i] = (n < 24) ? (bf16)f2bf(win[((size_t)ln * D + k) * INW + 3072 + n]) : (bf16)0; }
    for (int i = F.vcu * NT + F.tid; i < DEPTH * 48 * 1024; i += 256 * NT) { const int ln = i / (48 * 1024), n = (i >> 10) % 48, k = i & 1023;
        float v = 0.f; if (n < 4) v = rg[((size_t)ln * D + k) * 4 + n]; else if (n < 36) v = re[((size_t)ln * D + k) * 32 + (n - 4)];
        const unsigned h = f2bf(v); wrh[i] = (bf16)h; wrl[i] = (bf16)f2bf(v - bf2f((bf16)h)); }
}
constexpr int LN_PITCH = 1032, LN_XH = 0, LN_XL = 16 * LN_PITCH * 2, LN_PART = 2 * 16 * LN_PITCH * 2, LN_LGA = LN_PART + 8 * 16 * 48 * 4;
__device__ __forceinline__ int ln_col(int lane, int j) { return 8 * lane + 512 * (j >> 1) + 4 * (j & 1); }
template <int MODE> __device__ __forceinline__ void ln_rows_load(Frame& F, unsigned char* ws, int m, int lane, f32x4 (&a)[4], v2u (&y0)[4], v2u (&y1)[4], v2u (&yx)[4]) {
    if (MODE == 0) {
#pragma unroll
        for (int j = 0; j < 4; ++j) a[j] = *(const f32x4*)(inp(F, 0) + (size_t)m * D + ln_col(lane, j));
    } else {
#pragma unroll
        for (int jj = 0; jj < 2; ++jj) { const size_t o = (size_t)m * D + 8 * lane + 512 * jj;
            if (MODE == 1) { const v4u t = *(const v4u*)((const bf16*)(ws + WS_S + 64 * MiB) + o); yx[2 * jj] = (v2u){t.x, t.y}; yx[2 * jj + 1] = (v2u){t.z, t.w}; }
            else { const v4u t = *(const v4u*)((const bf16*)(ws + WS_XB) + o), p = *(const v4u*)((const bf16*)(ws + WS_YS) + o), q = *(const v4u*)((const bf16*)(ws + WS_YS) + (size_t)M * D + o);
                yx[2 * jj] = (v2u){t.x, t.y}; yx[2 * jj + 1] = (v2u){t.z, t.w}; y0[2 * jj] = (v2u){p.x, p.y}; y0[2 * jj + 1] = (v2u){p.z, p.w}; y1[2 * jj] = (v2u){q.x, q.y}; y1[2 * jj + 1] = (v2u){q.z, q.w}; } }
    }
}
template <int MODE> __device__ __forceinline__ void ln_phase(Frame& F, int l, float* outp) {
    unsigned char* ws = wsp(F); const int lane = F.lane, w = F.wave, tid = F.tid;
    LAS bf16* xh = (LAS bf16*)(F.lds + LN_XH); LAS bf16* xl = (LAS bf16*)(F.lds + LN_XL); LAS float* part = (LAS float*)(F.lds + LN_PART); LAS float* lga = (LAS float*)(F.lds + LN_LGA);
    const int lnext = (MODE == 0) ? 0 : l + 1; const bool proj = (MODE == 1) || (lnext < DEPTH);
    constexpr int NTL = (MODE == 1) ? 3 : 2;
    f32x4 ra[2][2][4]; v2u ry0[2][2][4], ry1[2][2][4], ryx[2][2][4];
#pragma unroll
    for (int rr = 0; rr < 2; ++rr) ln_rows_load<MODE>(F, ws, F.bid * 64 + 2 * w + rr, lane, ra[0][rr], ry0[0][rr], ry1[0][rr], ryx[0][rr]);
    __builtin_amdgcn_sched_barrier(0);
    f32x4 g4[4], b4[4];
    if (MODE != 0) { const float* gp = inp(F, MODE == 1 ? 23 : 32) + (size_t)l * D; const float* bp = inp(F, MODE == 1 ? 24 : 33) + (size_t)l * D;
#pragma unroll
        for (int j = 0; j < 4; ++j) { g4[j] = *(const f32x4*)(gp + ln_col(lane, j)); b4[j] = *(const f32x4*)(bp + ln_col(lane, j)); } }
    bf16x8 wb1[4][NTL], wb2[4][NTL];
    if (proj) { const int fr = lane & 15, fq = lane >> 4;
        const bf16* bh = (MODE == 1) ? (const bf16*)(ws + WS_WRH) + ((size_t)l * 48 + fr) * 1024 + 8 * fq + 128 * w : (const bf16*)(ws + WS_WGT) + ((size_t)lnext * 32 + fr) * 1024 + 8 * fq + 128 * w;
        const bf16* bl = (const bf16*)(ws + WS_WRL) + ((size_t)l * 48 + fr) * 1024 + 8 * fq + 128 * w;
#pragma unroll
        for (int k4 = 0; k4 < 4; ++k4)
#pragma unroll
            for (int nt = 0; nt < NTL; ++nt) {
                if (MODE == 0) {
                    const int n = 16 * nt + fr; const float* wp = inp(F, 2) + (size_t)(128 * w + 32 * k4 + 8 * fq) * INW + 3072 + (n < 24 ? n : 0); float f[8];
#pragma unroll
                    for (int j = 0; j < 8; ++j) { const float t = wp[(size_t)j * INW]; f[j] = n < 24 ? t : 0.f; }
                    const v4u pk = (v4u){cvtpk(f[0], f[1]), cvtpk(f[2], f[3]), cvtpk(f[4], f[5]), cvtpk(f[6], f[7])}; wb1[k4][nt] = __builtin_bit_cast(bf16x8, pk);
                } else { wb1[k4][nt] = *(const bf16x8*)(bh + (size_t)nt * 16 * 1024 + 32 * k4); if (MODE == 1) wb2[k4][nt] = *(const bf16x8*)(bl + (size_t)nt * 16 * 1024 + 32 * k4); } } }
#pragma unroll
    for (int bt = 0; bt < 4; ++bt) {
        const int m0 = F.bid * 64 + bt * 16;
        if (bt + 1 < 4) {
#pragma unroll
            for (int rr = 0; rr < 2; ++rr) ln_rows_load<MODE>(F, ws, m0 + 16 + 2 * w + rr, lane, ra[(bt + 1) & 1][rr], ry0[(bt + 1) & 1][rr], ry1[(bt + 1) & 1][rr], ryx[(bt + 1) & 1][rr]);
        }
        __syncthreads();
#pragma unroll
        for (int rr = 0; rr < 2; ++rr) {
            const int row = 2 * w + rr, m = m0 + row;
            f32x4 v[4];
#pragma unroll
            for (int j = 0; j < 4; ++j) { if (MODE == 0) v[j] = ra[bt & 1][rr][j];
                if (MODE == 1) { const v2u x = ryx[bt & 1][rr][j]; v[j] = (f32x4){bflo(x.x), bfhi(x.x), bflo(x.y), bfhi(x.y)}; }
                if (MODE == 2) { const v2u p = ry0[bt & 1][rr][j], q = ry1[bt & 1][rr][j], x = ryx[bt & 1][rr][j];
                    v[j] = (f32x4){bflo(x.x), bfhi(x.x), bflo(x.y), bfhi(x.y)} * ALPHA + ((f32x4){bflo(p.x), bfhi(p.x), bflo(p.y), bfhi(p.y)} + (f32x4){bflo(q.x), bfhi(q.x), bflo(q.y), bfhi(q.y)}); } }
            if (MODE != 0) {
                float s = 0.f;
#pragma unroll
                for (int j = 0; j < 4; ++j) s += (v[j].x + v[j].y) + (v[j].z + v[j].w);
                const float mean = wave_sum(s) * (1.f / D); float s2 = 0.f;
#pragma unroll
                for (int j = 0; j < 4; ++j) { v[j] = v[j] - mean; s2 += (v[j].x * v[j].x + v[j].y * v[j].y) + (v[j].z * v[j].z + v[j].w * v[j].w); }
                const float rstd = 1.f / sqrtf(wave_sum(s2) * (1.f / D) + LN_EPS);
#pragma unroll
                for (int j = 0; j < 4; ++j) v[j] = v[j] * rstd * g4[j] + b4[j];
                if (MODE == 2 && outp) {
#pragma unroll
                    for (int j = 0; j < 4; ++j) *(f32x4*)(outp + (size_t)m * D + ln_col(lane, j)) = v[j]; }
            }
            bf16* xb = (bf16*)(ws + WS_XB);
#pragma unroll
            for (int jj = 0; jj < 2; ++jj) { const f32x4 va = v[2 * jj], vb = v[2 * jj + 1];
                const v4u o = (v4u){pk2(va.x, va.y), pk2(va.z, va.w), pk2(vb.x, vb.y), pk2(vb.z, vb.w)};
                if (!(MODE == 2 && outp)) st_wt_nb(xb + (size_t)m * D + 8 * lane + 512 * jj, o);
                if (proj) { *(LAS v4u*)(xh + row * LN_PITCH + 8 * lane + 512 * jj) = o;
                    if (MODE == 1) { const v4u q = (v4u){pk2(va.x - bflo(o.x), va.y - bfhi(o.x)), pk2(va.z - bflo(o.y), va.w - bfhi(o.y)), pk2(vb.x - bflo(o.z), vb.y - bfhi(o.z)), pk2(vb.z - bflo(o.w), vb.w - bfhi(o.w))};
                        *(LAS v4u*)(xl + row * LN_PITCH + 8 * lane + 512 * jj) = q; } } }
        }
        if (!proj) continue;
        __syncthreads();
        {
            const int fr = lane & 15, fq = lane >> 4;
            pg8::f32x4 acc[NTL];
#pragma unroll
            for (int nt = 0; nt < NTL; ++nt) acc[nt] = (pg8::f32x4){0.f, 0.f, 0.f, 0.f};
            __builtin_amdgcn_sched_barrier(0);
#pragma unroll
            for (int k4 = 0; k4 < 4; ++k4) {
                const bf16x8 ah = *(const LAS bf16x8*)(xh + fr * LN_PITCH + 128 * w + 32 * k4 + 8 * fq);
                bf16x8 al; if (MODE == 1) al = *(const LAS bf16x8*)(xl + fr * LN_PITCH + 128 * w + 32 * k4 + 8 * fq);
#pragma unroll
                for (int nt = 0; nt < NTL; ++nt) {
                    acc[nt] = __builtin_amdgcn_mfma_f32_16x16x32_bf16(ah, wb1[k4][nt], acc[nt], 0, 0, 0);
                    if (MODE == 1) { acc[nt] = __builtin_amdgcn_mfma_f32_16x16x32_bf16(ah, wb2[k4][nt], acc[nt], 0, 0, 0);
                        acc[nt] = __builtin_amdgcn_mfma_f32_16x16x32_bf16(al, wb1[k4][nt], acc[nt], 0, 0, 0); } } }
#pragma unroll
            for (int nt = 0; nt < NTL; ++nt)
#pragma unroll
                for (int r = 0; r < 4; ++r) part[(w * 16 + 4 * fq + r) * 48 + 16 * nt + fr] = acc[nt][r];
        }
        __syncthreads();
        for (int i = tid; i < 16 * 16 * NTL; i += NT) { const int row = i / (16 * NTL), n = i % (16 * NTL); float s = 0.f;
#pragma unroll
            for (int w8 = 0; w8 < 8; ++w8) s += part[(w8 * 16 + row) * 48 + n];
            lga[(bt * 16 + row) * 48 + n] = s; }
    }
    __syncthreads();
    if (proj) {
        if (MODE != 1) {
            for (int i = tid; i < 64 * 24; i += NT) { const int tk = i / 24, n = i % 24; ((float*)(ws + WS_GATES))[(size_t)(F.bid * 64 + tk) * 24 + n] = lga[tk * 48 + n]; }
        } else if (tid < 64) {
            const LAS float* q = lga + tid * 48; const int m = F.bid * 64 + tid;
            const float* bg = inp(F, 26) + l * 4; const float* be = inp(F, 28) + l * 32;
            int grp = 0; float gm = q[0] + bg[0];
#pragma unroll
            for (int n = 1; n < 4; ++n) { const float a = q[n] + bg[n]; if (a > gm) { gm = a; grp = n; } }
            float gs = 0.f;
#pragma unroll
            for (int n = 0; n < 4; ++n) gs += __expf(q[n] + bg[n] - gm);
            const float pgrp = 1.f / gs;
            int i0 = 0, i1 = -1; float v0 = -3.0e38f, v1 = -3.0e38f;
            float ev[8];
#pragma unroll
            for (int i = 0; i < 8; ++i) ev[i] = q[4 + grp * 8 + i] + be[grp * 8 + i];
#pragma unroll
            for (int i = 0; i < 8; ++i) { const float a = ev[i]; if (a > v0) { v1 = v0; i1 = i0; v0 = a; i0 = i; } else if (a > v1) { v1 = a; i1 = i; } }
            const float w0 = 1.f / (1.f + __expf(v1 - v0)), w1 = 1.f - w0;
            const int e0 = grp * 8 + i0, e1 = grp * 8 + i1;
            LAS unsigned* lc = (LAS unsigned*)(F.lds + LN_LGA + 64 * 48 * 4);
            lc[tid] = 0u;
            asm volatile("s_waitcnt lgkmcnt(0)" ::: "memory");
            const unsigned r0 = __hip_atomic_fetch_add(lc + e0, 1u, __ATOMIC_RELAXED, __HIP_MEMORY_SCOPE_WORKGROUP);
            const unsigned r1 = __hip_atomic_fetch_add(lc + e1, 1u, __ATOMIC_RELAXED, __HIP_MEMORY_SCOPE_WORKGROUP);
            asm volatile("s_waitcnt lgkmcnt(0)" ::: "memory");
            if (tid < 32) { const unsigned c = lc[tid]; unsigned bs = 0u; if (c) bs = __hip_atomic_fetch_add((unsigned*)(F.ctl + CW_CNT + (l * 32 + tid) * 64), c, RLX_AGENT); lc[32 + tid] = bs; }
            asm volatile("s_waitcnt vmcnt(0) lgkmcnt(0)" ::: "memory");
            const unsigned p0 = lc[32 + e0] + r0, p1 = lc[32 + e1] + r1;
            ((unsigned*)(ws + WS_LISTS))[(size_t)e0 * M + p0] = (unsigned)(m * 2); ((unsigned*)(ws + WS_LISTS))[(size_t)e1 * M + p1] = (unsigned)(m * 2 + 1);
            ((float*)(ws + WS_SLOTW))[(size_t)m * 2] = w0 * pgrp; ((float*)(ws + WS_SLOTW))[(size_t)m * 2 + 1] = w1 * pgrp;
            ((float*)(ws + WS_WLIST))[(size_t)e0 * M + p0] = w0 * pgrp; ((float*)(ws + WS_WLIST))[(size_t)e1 * M + p1] = w1 * pgrp;
        }
    }
    __syncthreads();
}

struct EpiBf16Store {
    static constexpr bool PERM = true, HAS_MID = false; bf16* O; int ldc; bf16* C2; bf16* C3;
    __device__ __forceinline__ void operator()(const pg8::f32x4 (&acc)[2][2][4][2], const pg8::Unit& u, int wr, int wc, int fr, int fq) const {
        const bool cmp = (u.pn == CMP_PN), lor = (u.pn == LOR_PN);
        bf16* base = cmp ? C2 : (lor ? C3 : O + u.pn * 256); const int ld = (cmp || lor) ? 256 : ldc;
        const int row0 = u.pm * 256 + wr * 64 + fr, col0 = wc * 32 + 8 * fq;
#pragma unroll
        for (int ai = 0; ai < 2; ++ai)
#pragma unroll
            for (int m = 0; m < 4; ++m) { bf16* rowp = base + (size_t)(row0 + ai * 128 + m * 16) * ld + col0;
#pragma unroll
                for (int bj = 0; bj < 2; ++bj) { const pg8::f32x4 v0 = acc[ai][bj][m][0], v1 = acc[ai][bj][m][1]; v4u w;
                    w.x = cvtpk(v0[0], v0[1]); w.y = cvtpk(v0[2], v0[3]); w.z = cvtpk(v1[0], v1[1]); w.w = cvtpk(v1[2], v1[3]);
                    st_wt(rowp + bj * 128, w); } }
    }
};
struct EpiLora {
    static constexpr bool PERM = false, HAS_MID = false; float* Wd; bf16 *KP, *Bv, *Gv; const bf16* KK; const float *w0, *a0, *ka;
    __device__ __forceinline__ void operator()(const pg8::f32x4 (&acc)[2][2][4][2], const pg8::Unit& u, int wr, int wc, int fr, int fq) const {
        const int row0 = u.pm * 256 + wr * 64 + fr, type = u.pn >> 1, cb = (u.pn & 1) * 256 + wc * 32 + 4 * fq;
        if (type == 0) {
#pragma unroll
            for (int bj = 0; bj < 2; ++bj)
#pragma unroll
                for (int n = 0; n < 2; ++n) { const int c = cb + bj * 128 + n * 16; const pg8::f32x4 b4 = *(const pg8::f32x4*)(w0 + c);
#pragma unroll
                    for (int ai = 0; ai < 2; ++ai)
#pragma unroll
                        for (int m = 0; m < 4; ++m) { const size_t ro = (size_t)(row0 + ai * 128 + m * 16) * CW; const pg8::f32x4 a4 = acc[ai][bj][m][n]; pg8::f32x4 o;
#pragma unroll
                            for (int i = 0; i < 4; ++i) { const float y = -(b4[i] + a4[i]); const float sp = fmaxf(y, 0.f) + __logf(1.f + __expf(-fabsf(y))); o[i] = __expf(-__expf(-sp - 0.5f)); }
                            *(pg8::f32x4*)(Wd + ro + c) = o; asm volatile("" ::: "memory"); } }
        } else if (type == 1) {
#pragma unroll
            for (int bj = 0; bj < 2; ++bj)
#pragma unroll
                for (int n = 0; n < 2; ++n) { const int c = cb + bj * 128 + n * 16; const pg8::f32x4 b4 = *(const pg8::f32x4*)(a0 + c), ka4 = *(const pg8::f32x4*)(ka + c);
#pragma unroll
                    for (int ai = 0; ai < 2; ++ai)
#pragma unroll
                        for (int m = 0; m < 4; ++m) { const size_t ro = (size_t)(row0 + ai * 128 + m * 16) * CW; const pg8::f32x4 a4 = acc[ai][bj][m][n];
                            const pg8::f32x4 k4 = ld_bf4(KP + ro + c), kk4 = ld_bf4(KK + ro + c); pg8::f32x4 o1, o2;
#pragma unroll
                            for (int i = 0; i < 4; ++i) { const float a = 1.f / (1.f + __expf(-(b4[i] + a4[i]))); o1[i] = k4[i] * (1.f + (a - 1.f) * ka4[i]); o2[i] = kk4[i] * a; }
                            *(v2u*)(KP + ro + c) = (v2u){pk2(o1[0], o1[1]), pk2(o1[2], o1[3])}; *(v2u*)(Bv + ro + c) = (v2u){pk2(o2[0], o2[1]), pk2(o2[2], o2[3])}; asm volatile("" ::: "memory"); } }
        } else {
#pragma unroll
            for (int bj = 0; bj < 2; ++bj)
#pragma unroll
                for (int n = 0; n < 2; ++n) { const int c = cb + bj * 128 + n * 16;
#pragma unroll
                    for (int ai = 0; ai < 2; ++ai)
#pragma unroll
                        for (int m = 0; m < 4; ++m) { const size_t ro = (size_t)(row0 + ai * 128 + m * 16) * CW; { const pg8::f32x4 a4 = acc[ai][bj][m][n]; *(v2u*)(Gv + ro + c) = (v2u){pk2(a4[0], a4[1]), pk2(a4[2], a4[3])}; } } }
        }
    }
};
struct EpiUpM {
    static constexpr bool PERM = true, HAS_MID = true; const bf16* Z; bf16* Mg;
    __device__ __forceinline__ void mid_load(const pg8::Unit& u, int wr, int wc, int fr, int fq, int ai, int mp, v4u (&gr)[2][2], v4u (&gn)[2][2]) const {
        int rw = u.pm * 256 + wr * 64 + fr + ai * 128 + mp * 32; int c0 = u.pn * 256 + wc * 32 + 8 * fq; asm volatile("" : "+v"(rw), "+v"(c0));
        GAS const bf16* zb_ = (GAS const bf16*)Z; asm volatile("" : "+s"(zb_)); const bf16* zb = (const bf16*)zb_;
#pragma unroll
        for (int mm = 0; mm < 2; ++mm)
#pragma unroll
            for (int bj = 0; bj < 2; ++bj) { const unsigned o = (unsigned)(rw + 16 * mm) * (unsigned)ZW + (unsigned)(c0 + bj * 128);
                gr[mm][bj] = *(const v4u*)(zb + (o + (unsigned)ZC_GRW)); gn[mm][bj] = *(const v4u*)(zb + (o + (unsigned)ZC_GNSA)); }
    }
    __device__ __forceinline__ void mid_fac(const v4u (&gr)[2][2], const v4u (&gn)[2][2], pg8::f32x4 (&f)[2][2][2]) const {
#pragma unroll
        for (int mm = 0; mm < 2; ++mm)
#pragma unroll
            for (int bj = 0; bj < 2; ++bj)
#pragma unroll
                for (int n = 0; n < 2; ++n) { const unsigned a0 = n ? gr[mm][bj].z : gr[mm][bj].x, a1 = n ? gr[mm][bj].w : gr[mm][bj].y, b0 = n ? gn[mm][bj].z : gn[mm][bj].x, b1 = n ? gn[mm][bj].w : gn[mm][bj].y;
                    const pg8::f32x4 r4 = (pg8::f32x4){bflo(a0), bfhi(a0), bflo(a1), bfhi(a1)}, n4 = (pg8::f32x4){bflo(b0), bfhi(b0), bflo(b1), bfhi(b1)};
#pragma unroll
                    for (int i = 0; i < 4; ++i) f[mm][bj][n][i] = (1.f + __builtin_amdgcn_exp2f(n4[i] * -1.4426950408889634f)) * __builtin_amdgcn_rcpf(1.f + __builtin_amdgcn_exp2f(r4[i] * -1.4426950408889634f)); }
    }
    __device__ __forceinline__ void operator()(const pg8::f32x4 (&acc)[2][2][4][2], const pg8::Unit& u, int wr, int wc, int fr, int fq) const {
        GAS const bf16* zb_ = (GAS const bf16*)Z; GAS bf16* mg_ = (GAS bf16*)Mg; asm volatile("" : "+s"(zb_), "+s"(mg_)); const bf16* zb = (const bf16*)zb_; bf16* mg = (bf16*)mg_;
        int row0 = u.pm * 256 + wr * 64 + fr; asm volatile("" : "+v"(row0)); const int col0 = u.pn * 256 + wc * 32 + 8 * fq;
#pragma unroll
        for (int ai = 0; ai < 2; ++ai) {
            v4u g[4][2];
#pragma unroll
            for (int m = 0; m < 4; ++m)
#pragma unroll
                for (int bj = 0; bj < 2; ++bj) g[m][bj] = *(const v4u*)(zb + ((unsigned)(row0 + ai * 128 + m * 16) * (unsigned)ZW + (unsigned)(ZC_GNSA + col0 + bj * 128)));
            __builtin_amdgcn_sched_barrier(0);
#pragma unroll
            for (int m = 0; m < 4; ++m) { const unsigned row = (unsigned)(row0 + ai * 128 + m * 16);
#pragma unroll
                for (int bj = 0; bj < 2; ++bj) { const v4u gg = g[m][bj]; const pg8::f32x4 a4 = acc[ai][bj][m][0], b4 = acc[ai][bj][m][1];
                    v4u w; w.x = cvtpk(a4[0] * sigmoidf_(bflo(gg.x)), a4[1] * sigmoidf_(bfhi(gg.x))); w.y = cvtpk(a4[2] * sigmoidf_(bflo(gg.y)), a4[3] * sigmoidf_(bfhi(gg.y)));
                    w.z = cvtpk(b4[0] * sigmoidf_(bflo(gg.z)), b4[1] * sigmoidf_(bfhi(gg.z))); w.w = cvtpk(b4[2] * sigmoidf_(bflo(gg.w)), b4[3] * sigmoidf_(bfhi(gg.w)));
                    st_wt(mg + (row * (unsigned)D + (unsigned)(col0 + bj * 128)), w); } }
            asm volatile("" ::: "memory"); }
    }
};
struct EpiOut {
    static constexpr bool PERM = true, HAS_MID = false; const bf16* xres; bf16* pre;
    __device__ __forceinline__ void operator()(const pg8::f32x4 (&acc)[2][2][4][2], const pg8::Unit& u, int wr, int wc, int fr, int fq) const {
        const int row0 = u.pm * 256 + wr * 64 + fr, col0 = u.pn * 256 + wc * 32 + 8 * fq;
#pragma unroll
        for (int ai = 0; ai < 2; ++ai) {
            v4u x[4][2];
#pragma unroll
            for (int m = 0; m < 4; ++m)
#pragma unroll
                for (int bj = 0; bj < 2; ++bj) x[m][bj] = *(const v4u*)(xres + (size_t)(row0 + ai * 128 + m * 16) * D + col0 + bj * 128);
            __builtin_amdgcn_sched_barrier(0);
#pragma unroll
            for (int m = 0; m < 4; ++m) { const size_t ro = (size_t)(row0 + ai * 128 + m * 16) * D;
#pragma unroll
                for (int bj = 0; bj < 2; ++bj) { const v4u xx = x[m][bj];
                    const pg8::f32x4 p0 = (pg8::f32x4){bflo(xx.x), bfhi(xx.x), bflo(xx.y), bfhi(xx.y)} * ALPHA + acc[ai][bj][m][0], p1 = (pg8::f32x4){bflo(xx.z), bfhi(xx.z), bflo(xx.w), bfhi(xx.w)} * ALPHA + acc[ai][bj][m][1];
                    st_wt(pre + ro + col0 + bj * 128, (v4u){cvtpk(p0[0], p0[1]), cvtpk(p0[2], p0[3]), cvtpk(p1[0], p1[1]), cvtpk(p1[2], p1[3])}); } }
            asm volatile("" ::: "memory"); }
    }
};
struct EpiMoe1 {
    static constexpr bool PERM = true, HAS_MID = false; bf16* H;
    __device__ __forceinline__ void operator()(const pg8::f32x4 (&acc)[2][2][4][2], const pg8::Unit& u, int wr, int wc, int fr, int fq) const {
        const int row0 = u.pm * 256 + wr * 64 + fr, col0 = u.pn * 128 + wc * 32 + 8 * fq;
#pragma unroll
        for (int ai = 0; ai < 2; ++ai)
#pragma unroll
            for (int m = 0; m < 4; ++m) { float o[8];
#pragma unroll
                for (int n = 0; n < 2; ++n)
#pragma unroll
                    for (int i = 0; i < 4; ++i) { const float a = acc[ai][0][m][n][i], b = acc[ai][1][m][n][i]; o[4 * n + i] = a * sigmoidf_(a) * b; }
                v4u w; w.x = cvtpk(o[0], o[1]); w.y = cvtpk(o[2], o[3]); w.z = cvtpk(o[4], o[5]); w.w = cvtpk(o[6], o[7]);
                st_wt(H + (size_t)(row0 + ai * 128 + m * 16) * DEXP + col0, w); }
    }
};
struct EpiMoe2 {
    static constexpr bool PERM = true, HAS_MID = false; bf16* YS; const unsigned* lists; const float* wlist;
    __device__ __forceinline__ void operator()(const pg8::f32x4 (&acc)[2][2][4][2], const pg8::Unit& u, int wr, int wc, int fr, int fq) const {
        const int col0 = u.pn * 256 + wc * 32 + 8 * fq;
        unsigned en[2][4]; float w[2][4];
#pragma unroll
        for (int ai = 0; ai < 2; ++ai)
#pragma unroll
            for (int m = 0; m < 4; ++m) { const int r = ai * 128 + wr * 64 + m * 16 + fr; const size_t li = (size_t)u.e * M + u.mt * 256 + (r < u.rows ? r : 0); en[ai][m] = lists[li]; w[ai][m] = wlist[li]; }
        __builtin_amdgcn_sched_barrier(0);
#pragma unroll
        for (int ai = 0; ai < 2; ++ai)
#pragma unroll
            for (int m = 0; m < 4; ++m) { const int r = ai * 128 + wr * 64 + m * 16 + fr;
                if (r < u.rows) { const unsigned e1 = en[ai][m]; const float wt = w[ai][m]; bf16* op = YS + ((size_t)(e1 & 1u) * M + (e1 >> 1)) * D + col0;
#pragma unroll
                    for (int bj = 0; bj < 2; ++bj) { const pg8::f32x4 a4 = acc[ai][bj][m][0] * wt, b4 = acc[ai][bj][m][1] * wt; st_wt(op + bj * 128, (v4u){pk2(a4[0], a4[1]), pk2(a4[2], a4[3]), pk2(b4[0], b4[1]), pk2(b4[2], b4[3])}); } } }
    }
};
struct MoeOrder {
    const LAS int* tb; const LAS int* cn; const unsigned* lists; int G, c, total; size_t bstride;
    __device__ __forceinline__ bool next(int i, pg8::Unit& u) const {
        const long L = (long)i * G + c; if (L >= (long)total * 4) return false;
        const int T = (int)(L >> 2);
        const int ln = (int)__builtin_amdgcn_mbcnt_hi(~0u, __builtin_amdgcn_mbcnt_lo(~0u, 0u)); const int tv = tb[ln < NEXP ? ln : NEXP];
        const int e = (int)__popcll(__ballot(ln >= 1 && ln < NEXP && T >= tv));
        const int mt = T - tb[e]; int rows = cn[e] - mt * 256; rows = rows > 256 ? 256 : rows;
        u.pm = __builtin_amdgcn_readfirstlane(T); u.pn = __builtin_amdgcn_readfirstlane((int)(L & 3)); u.e = __builtin_amdgcn_readfirstlane(e); u.rows = __builtin_amdgcn_readfirstlane(rows); u.mt = __builtin_amdgcn_readfirstlane(mt); return true;
    }
    __device__ __forceinline__ const char* b_base(const pg8::Gemm& g, const pg8::Unit& u, size_t tstep) const { return (const char*)g.Bt + (size_t)u.e * bstride + (size_t)u.pn * tstep; }
    __device__ __forceinline__ int arow(const pg8::Unit& u, int r) const { return r < u.rows ? (int)(lists[(size_t)u.e * M + u.mt * 256 + r] >> 1) : 0; }
};

__device__ __forceinline__ void prep_unit(Frame& F, int l, int tile) {
    unsigned char* ws = wsp(F); const int lane = F.lane;
    const bf16* Z = (const bf16*)(ws + WS_LOR) + 4 * lane;
    bf16* AP = (bf16*)(ws + WS_AP);
    const f32x4 mu4 = *(const f32x4*)(inp(F, 3) + (size_t)l * 1792 + 1536 + 4 * lane);
    const int m00 = tile * 64 + 8 * F.wave;
    v2u rows[9];
#pragma unroll
    for (int i = 0; i < 9; ++i) rows[i] = (v2u){0u, 0u};
    if ((m00 & (SEQ - 1)) > 0) rows[0] = *(const v2u*)(Z + (size_t)(m00 - 1) * 256);
#pragma unroll
    for (int i = 0; i < 8; ++i) rows[i + 1] = *(const v2u*)(Z + (size_t)(m00 + i) * 256);
#pragma unroll
    for (int i = 0; i < 8; ++i) {
        const f32x4 c4 = (f32x4){bflo(rows[i + 1].x), bfhi(rows[i + 1].x), bflo(rows[i + 1].y), bfhi(rows[i + 1].y)}, p4 = (f32x4){bflo(rows[i].x), bfhi(rows[i].x), bflo(rows[i].y), bfhi(rows[i].y)};
        const f32x4 zs = c4 + (p4 - c4) * mu4; f32x4 o;
        const float sc = lane < 16 ? 2.f : 1.f;
#pragma unroll
        for (int e = 0; e < 4; ++e) { const float sg = sigmoidf_(zs[e] * sc); o[e] = lane < 16 ? 2.f * sg - 1.f : (lane < 32 ? zs[e] : sg); }
        v2u w; w.x = pk2(o.x, o.y); w.y = pk2(o.z, o.w); *(v2u*)(AP + (size_t)(m00 + i) * 256 + 4 * lane) = w; }
}

__device__ __forceinline__ float gelu_tanh(float x) { const float u = 0.7978845608028654f * (x + 0.044715f * x * x * x); return 0.5f * x * (1.f + tanhf(u)); }
__device__ __forceinline__ void compress_unit(Frame& F, int unit) {
    unsigned char* ws = wsp(F); const int lane = F.lane, w = F.wave;
    const int b = unit >> 6, which = (unit >> 5) & 1, cg = (unit >> 1) & 15, g0 = unit & 1;
    const bf16* Z = (const bf16*)(ws + WS_Z);
    const bf16* W1 = (const bf16*)(ws + (which ? WS_WC1V : WS_WC1K)); const bf16* W2 = (const bf16*)(ws + (which ? WS_WC2V : WS_WC2K));
    const float* peb = (const float*)(ws + WS_PEB) + which * 128;
    LAS bf16* hid = (LAS bf16*)F.lds;
    LAS bf16* at = (LAS bf16*)(F.lds + 8192);
    const int fr = lane & 15, fq = lane >> 4;
    for (int g = g0; g <= g0; ++g) {
        pg8::f32x4 acc = (pg8::f32x4){0.f, 0.f, 0.f, 0.f};
        const bf16* bp = W1 + (size_t)(16 * w + fr) * 2048 + 8 * fq;
#define CU_LOADB(FB, q_) do { _Pragma("unroll") for (int s_ = 0; s_ < 16; ++s_) FB[s_] = *(const bf16x8*)(bp + 32 * (16 * (q_) + s_)); } while (0)
#define CU_MMA(FB, q_) do { _Pragma("unroll") for (int s_ = 0; s_ < 16; ++s_) acc = __builtin_amdgcn_mfma_f32_16x16x32_bf16(*(const LAS bf16x8*)(at + fr * 2056 + 32 * (16 * (q_) + s_) + 8 * fq), FB[s_], acc, 0, 0, 0); } while (0)
        bf16x8 b0[16], b1[16];
        CU_LOADB(b0, 0); CU_LOADB(b1, 1);
        { const bf16* src = (const bf16*)(ws + WS_CMP) + (size_t)b * SEQ * 256 + which * 128 + g * 64; v4u pc[8];
#pragma unroll
          for (int i = 0; i < 8; ++i) { const int idx = F.tid + 512 * i, cc = idx >> 8, jj = (idx >> 3) & 31, pce = idx & 7; int cgl = 16 * cg + cc; if (cgl > 254) cgl = 254;
              pc[i] = *(const v4u*)(src + (size_t)(16 * cgl + jj) * 256 + 8 * pce); }
          __syncthreads();
#pragma unroll
          for (int i = 0; i < 8; ++i) { const int idx = F.tid + 512 * i, cc = idx >> 8, jj = (idx >> 3) & 31, pce = idx & 7; *(LAS v4u*)(at + cc * 2056 + jj * 64 + 8 * pce) = pc[i]; } }
        __syncthreads();
        __builtin_amdgcn_sched_barrier(0);
        CU_MMA(b0, 0); __builtin_amdgcn_sched_barrier(0); CU_LOADB(b0, 2); __builtin_amdgcn_sched_barrier(0);
        CU_MMA(b1, 1); __builtin_amdgcn_sched_barrier(0); CU_LOADB(b1, 3); __builtin_amdgcn_sched_barrier(0);
        CU_MMA(b0, 2); CU_MMA(b1, 3);
#undef CU_LOADB
#undef CU_MMA
        const float pb = peb[16 * w + fr];
        __syncthreads();
#pragma unroll
        for (int r = 0; r < 4; ++r) hid[(4 * fq + r) * 136 + 16 * w + fr] = (bf16)f2bf(gelu_tanh(acc[r] + pb));
        __syncthreads();
        if (w < 4) {
            pg8::f32x4 a2 = (pg8::f32x4){0.f, 0.f, 0.f, 0.f};
#pragma unroll
            for (int ks = 0; ks < 4; ++ks) {
                const bf16x8 a = *(const LAS bf16x8*)(hid + fr * 136 + 32 * ks + 8 * fq);
                const bf16x8 bb = *(const bf16x8*)(W2 + (size_t)(16 * w + fr) * 128 + 32 * ks + 8 * fq);
                a2 = __builtin_amdgcn_mfma_f32_16x16x32_bf16(a, bb, a2, 0, 0, 0);
            }
            const int d = 16 * w + fr, c0 = 16 * cg + 4 * fq;
            if (which == 0) { bf16* KC = (bf16*)(ws + WS_KC);
#pragma unroll
                for (int r = 0; r < 4; ++r) KC[((size_t)(b * 2 + g) * 256 + c0 + r) * 64 + d] = (c0 + r < NCMP) ? (bf16)f2bf(a2[r]) : (bf16)0; }
            else { bf16* VCT = (bf16*)(ws + WS_VCT); v2u o; o.x = pk2(a2[0], a2[1]); o.y = pk2(a2[2], (c0 + 3 < NCMP) ? a2[3] : 0.f);
                *(v2u*)(VCT + ((size_t)(b * 2 + g) * 64 + d) * 256 + c0) = o; }
        }
    }
    __syncthreads();
}

constexpr int CK_A1 = 0, CK_A2 = 4096, CK_A3 = 5120, CK_GC = 9216, CK_VT = 9472, CK_BYTES = 11520, NCHUNK = SEQ / 16;
template <bool INCL, bool SELF> __device__ __forceinline__ void tri_apply(const LAS float* mat, float (&y)[16], const float (&xin)[16]) {
    pg8::f32x4 nc[4], nn[4];
    constexpr int T0 = INCL ? 0 : 1;
#pragma unroll
    for (int c = 0; c < 4; ++c) if (4 * c < T0 + (INCL ? 1 : 0)) nc[c] = *(const LAS pg8::f32x4*)(mat + T0 * 16 + 4 * c);
#pragma unroll
    for (int t = T0; t < 16; ++t) {
        const int cnt = INCL ? t + 1 : t;
        if (t + 1 < 16) {
#pragma unroll
            for (int c = 0; c < 4; ++c) if (4 * c < cnt + 1) nn[c] = *(const LAS pg8::f32x4*)(mat + (t + 1) * 16 + 4 * c); }
        float a0 = y[t], a1 = 0.f;
#pragma unroll
        for (int c = 0; c < 4; ++c)
#pragma unroll
            for (int i = 0; i < 4; ++i) if (4 * c + i < cnt) { const float xv = SELF ? y[4 * c + i] : xin[4 * c + i]; if ((4 * c + i) & 1) a1 += xv * nc[c][i]; else a0 += xv * nc[c][i]; }
        y[t] = a0 + a1;
        asm volatile("" ::: "memory");
#pragma unroll
        for (int c = 0; c < 4; ++c) nc[c] = nn[c];
    }
}
__device__ __forceinline__ void chunk_prep(Frame& F, int l, const float* w0, const float* a0, const float* ka) {
    unsigned char* ws = wsp(F); const int lane = F.lane;
    bf16* KP = (bf16*)(ws + WS_S + 3 * SARR); bf16* Gv = (bf16*)(ws + WS_S + 6 * SARR);
    const bf16* AP = (const bf16*)(ws + WS_AP); const bf16* WLW = (const bf16*)(ws + WS_WLORA); const bf16* WLA = WLW + 512 * 64; const bf16* WLG = WLA + 512 * 64;
    LAS float* sc = (LAS float*)(F.lds + F.wave * 16896); LAS unsigned char* scb = (LAS unsigned char*)sc;
    constexpr int TR = 10240, TK = 12416, TV = 14592;
    LAS unsigned short* tg = (LAS unsigned short*)(scb + 8192); LAS unsigned short* trr = (LAS unsigned short*)(scb + TR); LAS unsigned short* tkp = (LAS unsigned short*)(scb + TK); LAS unsigned short* tvv = (LAS unsigned short*)(scb + TV);
    const bf16* Zb = (const bf16*)(ws + WS_Z); bf16* Ro = (bf16*)(ws + WS_S); bf16* Vo = (bf16*)(ws + WS_S + SARR);
    const int tq = lane & 15, qq = lane >> 4, tt = lane >> 2, pp = lane & 3;
    const float w0c = w0[F.wave * 64 + lane], a0c = a0[F.wave * 64 + lane], kac = ka[F.wave * 64 + lane];
    const float* mu = inp(F, 3) + (size_t)l * 1792 + F.wave * 64 + lane; const float mur = mu[0], muk = mu[512], muv = mu[1024], kkwc = (inp(F, 9) + (size_t)l * CW)[F.wave * 64 + lane];
#define CP_LOADA(FA, k4_) do { const bf16* ap_ = AP + ((size_t)(F.bid >> 6) * SEQ + ((F.bid & 63) * 4 + (k4_)) * 16 + tq) * 256 + 8 * qq; \
        _Pragma("unroll") for (int ks_ = 0; ks_ < 8; ++ks_) FA[ks_] = *(const bf16x8*)(ap_ + 32 * ks_); } while (0)
    bf16x8 fa[8];
    for (int k4 = 0; k4 < 4; ++k4) {
        const int b = F.bid >> 6, h = F.wave, ch = (F.bid & 63) * 4 + k4, bh = b * 8 + h, task = bh * NCHUNK + ch;
        const size_t wbase = ((size_t)b * SEQ + ch * 16 + tt) * CW + h * 64 + 16 * pp;
        unsigned char* rec = ws + WS_CHK + (size_t)task * CK_BYTES;
        const size_t base = ((size_t)b * SEQ + ch * 16) * CW + h * 64 + lane;
        v4u ik[6], ipv; unsigned vr[16];
        CP_LOADA(fa, k4);
        {
          LDS_WAIT(); asm volatile("" ::: "memory");
          { const bf16* zr = Zb + ((size_t)b * SEQ + ch * 16 + tt) * ZW + h * 64 + 16 * pp;
            ik[0] = *(const v4u*)(zr + ZC_R); ik[1] = *(const v4u*)(zr + ZC_R + 8); ik[2] = *(const v4u*)(zr + ZC_K); ik[3] = *(const v4u*)(zr + ZC_K + 8); ik[4] = *(const v4u*)(zr + ZC_V); ik[5] = *(const v4u*)(zr + ZC_V + 8);
            ipv = (v4u){0u, 0u, 0u, 0u};
            if (lane < 24 && ch > 0) ipv = *(const v4u*)(Zb + ((size_t)b * SEQ + ch * 16 - 1) * ZW + h * 64 + (lane >> 3) * 512 + 8 * (lane & 7)); }
#define CP_LOADQ(BW, nt_) do { const int c_ = h * 64 + 16 * (nt_) + tq; \
              _Pragma("unroll") for (int ks_ = 0; ks_ < 2; ++ks_) { BW[ks_] = *(const bf16x8*)(WLW + (size_t)c_ * 64 + 32 * ks_ + 8 * qq); BW[2 + ks_] = *(const bf16x8*)(WLA + (size_t)c_ * 64 + 32 * ks_ + 8 * qq); } \
              _Pragma("unroll") for (int ks_ = 0; ks_ < 4; ++ks_) BW[4 + ks_] = *(const bf16x8*)(WLG + (size_t)c_ * 128 + 32 * ks_ + 8 * qq); } while (0)
#define CP_MMAQ(BW, nt_) do { pg8::f32x4 dw = (pg8::f32x4){0.f, 0.f, 0.f, 0.f}, da = dw, dg = dw; \
              _Pragma("unroll") for (int ks_ = 0; ks_ < 2; ++ks_) { dw = __builtin_amdgcn_mfma_f32_16x16x32_bf16(fa[ks_], BW[ks_], dw, 0, 0, 0); da = __builtin_amdgcn_mfma_f32_16x16x32_bf16(fa[2 + ks_], BW[2 + ks_], da, 0, 0, 0); } \
              _Pragma("unroll") for (int ks_ = 0; ks_ < 4; ++ks_) dg = __builtin_amdgcn_mfma_f32_16x16x32_bf16(fa[4 + ks_], BW[4 + ks_], dg, 0, 0, 0); \
              _Pragma("unroll") for (int r_ = 0; r_ < 4; ++r_) { sc[(4 * qq + r_) * 64 + 16 * (nt_) + tq] = dw[r_]; sc[1024 + (4 * qq + r_) * 64 + 16 * (nt_) + tq] = da[r_]; tg[(4 * qq + r_) * 64 + 16 * (nt_) + tq] = (unsigned short)f2bf(dg[r_]); } } while (0)
          { bf16x8 bw0[8], bw1[8], bw2[8];
            CP_LOADQ(bw0, 0); CP_LOADQ(bw1, 1); CP_LOADQ(bw2, 2); __builtin_amdgcn_sched_barrier(0);
            CP_MMAQ(bw0, 0); __builtin_amdgcn_sched_barrier(0); CP_LOADQ(bw0, 3); __builtin_amdgcn_sched_barrier(0);
            CP_MMAQ(bw1, 1); CP_MMAQ(bw2, 2); __builtin_amdgcn_sched_barrier(0); CP_MMAQ(bw0, 3); }
#undef CP_LOADQ
#undef CP_MMAQ
          *(LAS v4u*)(scb + TR + (tt + 1) * 128 + pp * 32) = ik[0]; *(LAS v4u*)(scb + TR + (tt + 1) * 128 + pp * 32 + 16) = ik[1];
          *(LAS v4u*)(scb + TK + (tt + 1) * 128 + pp * 32) = ik[2]; *(LAS v4u*)(scb + TK + (tt + 1) * 128 + pp * 32 + 16) = ik[3];
          *(LAS v4u*)(scb + TV + (tt + 1) * 128 + pp * 32) = ik[4]; *(LAS v4u*)(scb + TV + (tt + 1) * 128 + pp * 32 + 16) = ik[5];
          if (lane < 24) *(LAS v4u*)(scb + TR + (lane >> 3) * (TK - TR) + (lane & 7) * 16) = ipv;
          LDS_WAIT(); asm volatile("" ::: "memory"); }
        float al[16], be[16], kb[16], rb[16];
        float g = 1.f;
        { float pr = bf2f(trr[lane]), pk = bf2f(tkp[lane]), pv = bf2f(tvv[lane]);
#pragma unroll
          for (int t = 0; t < 16; ++t) {
              const float cr = bf2f(trr[(t + 1) * 64 + lane]), ck = bf2f(tkp[(t + 1) * 64 + lane]), cv = bf2f(tvv[(t + 1) * 64 + lane]);
              const float rsh = cr + (pr - cr) * mur, kraw = ck + (pk - ck) * muk, vsh = cv + (pv - cv) * muv; pr = cr; pk = ck; pv = cv;
              const unsigned rvb = cvtpk(rsh, vsh); const float rv = bflo(rvb); vr[t] = rvb >> 16;
              trr[(t + 1) * 64 + lane] = (unsigned short)rvb; tvv[(t + 1) * 64 + lane] = (unsigned short)(rvb >> 16);
              const float kq = kraw * kkwc; const float kkv = kq * __builtin_amdgcn_rcpf(fmaxf(__builtin_amdgcn_sqrtf(wave_sum(kq * kq)), 1e-12f));
              const float yw = -(w0c + sc[t * 64 + lane]); const float sp = fmaxf(yw, 0.f) + __logf(1.f + __expf(-fabsf(yw))); const float wv = __expf(-__expf(-sp - 0.5f));
              const float av = __builtin_amdgcn_rcpf(1.f + __expf(-(a0c + sc[1024 + t * 64 + lane]))); const float bv = kkv * av, kpv = kraw * (1.f + (av - 1.f) * kac);
              tkp[(t + 1) * 64 + lane] = (unsigned short)f2bf(kpv);
              al[t] = -kkv * g; g *= wv; const float ig = __builtin_amdgcn_rcpf(g); be[t] = bv * ig; kb[t] = kpv * ig; rb[t] = rv * g; }
          *(v4u*)(rec + CK_VT + lane * 32) = (v4u){vr[0] | (vr[1] << 16), vr[2] | (vr[3] << 16), vr[4] | (vr[5] << 16), vr[6] | (vr[7] << 16)};
          *(v4u*)(rec + CK_VT + lane * 32 + 16) = (v4u){vr[8] | (vr[9] << 16), vr[10] | (vr[11] << 16), vr[12] | (vr[13] << 16), vr[14] | (vr[15] << 16)}; }
        ((float*)(rec + CK_GC))[lane] = g;
        LDS_WAIT(); asm volatile("" ::: "memory");
        { const v4u o0 = *(const LAS v4u*)(scb + TK + (tt + 1) * 128 + pp * 32), o1 = *(const LAS v4u*)(scb + TK + (tt + 1) * 128 + pp * 32 + 16), g0 = *(const LAS v4u*)(scb + 8192 + tt * 128 + pp * 32), g1 = *(const LAS v4u*)(scb + 8192 + tt * 128 + pp * 32 + 16);
          const v4u r0 = *(const LAS v4u*)(scb + TR + (tt + 1) * 128 + pp * 32), r1 = *(const LAS v4u*)(scb + TR + (tt + 1) * 128 + pp * 32 + 16), v0 = *(const LAS v4u*)(scb + TV + (tt + 1) * 128 + pp * 32), v1 = *(const LAS v4u*)(scb + TV + (tt + 1) * 128 + pp * 32 + 16);
          *(v4u*)(KP + wbase) = o0; *(v4u*)(KP + wbase + 8) = o1; *(v4u*)(Gv + wbase) = g0; *(v4u*)(Gv + wbase + 8) = g1;
          *(v4u*)(Ro + wbase) = r0; *(v4u*)(Ro + wbase + 8) = r1; *(v4u*)(Vo + wbase) = v0; *(v4u*)(Vo + wbase + 8) = v1; }
#pragma unroll
        for (int q = 0; q < 4; ++q) { v4u o; o.x = pk2(be[4 * q] * g, be[4 * q + 1] * g); o.y = pk2(be[4 * q + 2] * g, be[4 * q + 3] * g); o.z = pk2(kb[4 * q] * g, kb[4 * q + 1] * g); o.w = pk2(kb[4 * q + 2] * g, kb[4 * q + 3] * g);
            *(v4u*)(rec + CK_A3 + lane * 64 + 16 * q) = o; }
        LDS_WAIT(); asm volatile("" ::: "memory");
        { LAS unsigned short* ob = (LAS unsigned short*)scb;
#pragma unroll
          for (int t = 0; t < 16; ++t) { const unsigned p0 = cvtpk(be[t], kb[t]), p1 = cvtpk(al[t], rb[t]);
              ob[t * 72 + lane] = (unsigned short)p0; ob[1152 + t * 72 + lane] = (unsigned short)(p0 >> 16); ob[2304 + t * 72 + lane] = (unsigned short)p1; ob[3456 + t * 72 + lane] = (unsigned short)(p1 >> 16); } }
        LDS_WAIT(); asm volatile("" ::: "memory");
        pg8::f32x4 cab = (pg8::f32x4){0.f, 0.f, 0.f, 0.f}, cak = cab, crb = cab, crk = cab;
        { const LAS bf16* ob = (const LAS bf16*)scb + tq * 72 + 8 * qq;
#pragma unroll
          for (int kh = 0; kh < 2; ++kh) {
              const bf16x8 fbe = *(const LAS bf16x8*)(ob + 32 * kh), fkb = *(const LAS bf16x8*)(ob + 1152 + 32 * kh), fal = *(const LAS bf16x8*)(ob + 2304 + 32 * kh), frb = *(const LAS bf16x8*)(ob + 3456 + 32 * kh);
              cab = __builtin_amdgcn_mfma_f32_16x16x32_bf16(fbe, fal, cab, 0, 0, 0); cak = __builtin_amdgcn_mfma_f32_16x16x32_bf16(fkb, fal, cak, 0, 0, 0);
              crb = __builtin_amdgcn_mfma_f32_16x16x32_bf16(fbe, frb, crb, 0, 0, 0); crk = __builtin_amdgcn_mfma_f32_16x16x32_bf16(fkb, frb, crk, 0, 0, 0); } }
        LDS_WAIT(); asm volatile("" ::: "memory");
        { pg8::f32x4 m1, m2, m3, m4;
#pragma unroll
          for (int r = 0; r < 4; ++r) { const int i = 4 * qq + r; m1[r] = (i < tq) ? cab[r] : 0.f; m2[r] = (i < tq) ? cak[r] : 0.f; m3[r] = (i <= tq) ? crb[r] : 0.f; m4[r] = (i <= tq) ? crk[r] : 0.f; }
          *(LAS pg8::f32x4*)(sc + tq * 16 + 4 * qq) = m1; *(LAS pg8::f32x4*)(sc + 256 + tq * 16 + 4 * qq) = m2; *(LAS pg8::f32x4*)(sc + 512 + tq * 16 + 4 * qq) = m3; *(LAS pg8::f32x4*)(sc + 768 + tq * 16 + 4 * qq) = m4; }
        LDS_WAIT(); asm volatile("" ::: "memory");
        tri_apply<false, true>(sc, al, al);
        tri_apply<true, false>(sc + 512, rb, al);
        { const int pos = (lane & 32) + 8 * ((lane >> 2) & 3) + 4 * ((lane >> 4) & 1) + (lane & 3); LAS unsigned short* a1 = (LAS unsigned short*)(scb + 4096);
#pragma unroll
          for (int t = 0; t < 16; ++t) { a1[t * 64 + pos] = (unsigned short)f2bf(al[t]); a1[(16 + t) * 64 + pos] = (unsigned short)f2bf(rb[t]); } }
        if (lane < 16) { float pk[16], qv[16];
#pragma unroll
            for (int t = 0; t < 16; ++t) { pk[t] = sc[256 + t * 16 + lane]; qv[t] = sc[768 + t * 16 + lane]; }
            asm volatile("" ::: "memory");
            tri_apply<false, true>(sc, pk, pk);
            tri_apply<true, false>(sc + 512, qv, pk);
            LAS unsigned short* a2 = (LAS unsigned short*)(scb + 8192);
#pragma unroll
            for (int t = 0; t < 16; ++t) { a2[t * 16 + lane] = (unsigned short)f2bf(pk[t]); a2[(16 + t) * 16 + lane] = (unsigned short)f2bf(qv[t]); } }
        LDS_WAIT(); asm volatile("" ::: "memory");
#pragma unroll
        for (int i = 0; i < 4; ++i) *(v4u*)(rec + CK_A1 + (lane + 64 * i) * 16) = *(const LAS v4u*)(scb + 4096 + (lane + 64 * i) * 16);
        *(v4u*)(rec + CK_A2 + lane * 16) = *(const LAS v4u*)(scb + 8192 + lane * 16);
    }
#undef CP_LOADA
}
constexpr int CSCAN_BLOCKS = 32, CK_STAGE = 4 * CK_BYTES, CK_PIECES = CK_STAGE / 16, CK_NST = NCHUNK / 4;
__device__ __forceinline__ v2u cvt4_bf16(const pg8::f32x4& x) { v2u r; r.x = cvtpk(x[0], x[1]); r.y = cvtpk(x[2], x[3]); return r; }
__device__ __forceinline__ void chunk_scan(Frame& F, int l) {
    unsigned char* ws = wsp(F); const int lane = F.lane, w = F.wave, tid = F.tid;
    if (F.bid >= CSCAN_BLOCKS) return;
    const int bh = F.bid, b = bh >> 3, h = bh & 7, fr = lane & 15, q = lane >> 4;
    LAS float* ybuf = (LAS float*)(F.lds + 2 * CK_STAGE);
    const unsigned char* rec = ws + WS_CHK + (size_t)bh * NCHUNK * CK_BYTES;
    pg8::f32x4 st[4];
#pragma unroll
    for (int kt = 0; kt < 4; ++kt) st[kt] = (pg8::f32x4){0.f, 0.f, 0.f, 0.f};
    const bf16x8 zero8 = (bf16x8){0, 0, 0, 0, 0, 0, 0, 0};
    v4u ra[6], rb[6];
#define CS_LOAD(dst, s) do { _Pragma("unroll") for (int i = 0; i < 6; ++i) { const int idx = tid + 512 * i; if (idx < CK_PIECES) dst[i] = *(const v4u*)(rec + (size_t)(s) * CK_STAGE + (size_t)idx * 16); } } while (0)
#define CS_STORE(src, pb) do { _Pragma("unroll") for (int i = 0; i < 6; ++i) { const int idx = tid + 512 * i; if (idx < CK_PIECES) *(LAS v4u*)(F.lds + (pb) * CK_STAGE + idx * 16) = src[i]; } } while (0)
    const int ptk = (w - 4) * 16 + (lane >> 2), pc0 = h * 64 + (lane & 3) * 16;
    LAS float* prm = (LAS float*)(F.lds + 2 * CK_STAGE + 32768);
    if (tid < 192) prm[tid] = (inp(F, tid < 64 ? 12 : (tid < 128 ? 13 : 11)) + (size_t)l * CW)[h * 64 + (tid & 63)];
    v4u pr_[2], pk_[2], pv_[2], pg_[2];
#define CS_POST_LOAD(sp) do { if (w >= 4) { const size_t o_ = ((size_t)b * SEQ + (sp) * 64 + ptk) * CW + pc0; \
        _Pragma("unroll") for (int i_ = 0; i_ < 2; ++i_) { pr_[i_] = *(const v4u*)((const bf16*)(ws + WS_S) + o_ + 8 * i_); pk_[i_] = *(const v4u*)((const bf16*)(ws + WS_S + 3 * SARR) + o_ + 8 * i_); \
            pv_[i_] = *(const v4u*)((const bf16*)(ws + WS_S + SARR) + o_ + 8 * i_); pg_[i_] = *(const v4u*)((const bf16*)(ws + WS_S + 6 * SARR) + o_ + 8 * i_); } } } while (0)
#define CS_POST_RUN(sp) do { if (w >= 4) { const LAS float* lg_ = prm + (lane & 3) * 16; const LAS float* lb_ = lg_ + 64; const LAS float* rk_ = lg_ + 128; \
        float y_[16], s_ = 0.f, bn_ = 0.f; \
        _Pragma("unroll") for (int i_ = 0; i_ < 4; ++i_) { const f32x4 t_ = *(const LAS f32x4*)(ybuf + (((sp) & 1) * 64 + ptk) * 64 + (lane & 3) * 16 + 4 * i_); y_[4 * i_] = t_.x; y_[4 * i_ + 1] = t_.y; y_[4 * i_ + 2] = t_.z; y_[4 * i_ + 3] = t_.w; } \
        const unsigned rr_[8] = {pr_[0].x, pr_[0].y, pr_[0].z, pr_[0].w, pr_[1].x, pr_[1].y, pr_[1].z, pr_[1].w}, kk_[8] = {pk_[0].x, pk_[0].y, pk_[0].z, pk_[0].w, pk_[1].x, pk_[1].y, pk_[1].z, pk_[1].w}; \
        const unsigned vv_[8] = {pv_[0].x, pv_[0].y, pv_[0].z, pv_[0].w, pv_[1].x, pv_[1].y, pv_[1].z, pv_[1].w}, gg_[8] = {pg_[0].x, pg_[0].y, pg_[0].z, pg_[0].w, pg_[1].x, pg_[1].y, pg_[1].z, pg_[1].w}; \
        _Pragma("unroll") for (int i_ = 0; i_ < 8; ++i_) { s_ += y_[2 * i_] + y_[2 * i_ + 1]; bn_ += bflo(rr_[i_]) * bflo(kk_[i_]) * rk_[2 * i_] + bfhi(rr_[i_]) * bfhi(kk_[i_]) * rk_[2 * i_ + 1]; } \
        const float mu_ = sum4(s_) * (1.f / 64.f); bn_ = sum4(bn_); float q_ = 0.f; \
        _Pragma("unroll") for (int i_ = 0; i_ < 16; ++i_) { y_[i_] -= mu_; q_ += y_[i_] * y_[i_]; } \
        const float rstd_ = 1.f / sqrtf(sum4(q_) * (1.f / 64.f) + GN_EPS); unsigned o8_[8]; \
        _Pragma("unroll") for (int i_ = 0; i_ < 8; ++i_) { const float a_ = (y_[2 * i_] * rstd_ * lg_[2 * i_] + lb_[2 * i_] + bn_ * bflo(vv_[i_])) * bflo(gg_[i_]), b_ = (y_[2 * i_ + 1] * rstd_ * lg_[2 * i_ + 1] + lb_[2 * i_ + 1] + bn_ * bfhi(vv_[i_])) * bfhi(gg_[i_]); o8_[i_] = pk2(a_, b_); } \
        bf16* yo_ = (bf16*)(ws + WS_YRW) + ((size_t)b * SEQ + (sp) * 64 + ptk) * D + pc0; *(v4u*)yo_ = (v4u){o8_[0], o8_[1], o8_[2], o8_[3]}; *(v4u*)(yo_ + 8) = (v4u){o8_[4], o8_[5], o8_[6], o8_[7]}; } } while (0)
    __syncthreads();
    CS_LOAD(rb, 0); CS_STORE(rb, 0); CS_LOAD(rb, 1); CS_POST_LOAD(0);
    __syncthreads();
    for (int s2 = 0; s2 < CK_NST; s2 += 2) {
        { const int s = s2;
          if (s + 2 < CK_NST) CS_LOAD(ra, s + 2);
          if (s > 0) { CS_POST_RUN(s - 1); CS_POST_LOAD(s); }
        if (w < 4) {
            for (int c = 0; c < 4; ++c) {
                const LAS unsigned char* rp = F.lds + (s & 1) * CK_STAGE + c * CK_BYTES;
                bf16x8 c1[2][2], c2[2], c3[4], cv8; v2u cv4; pg8::f32x4 cg[4];
#pragma unroll
                for (int mt = 0; mt < 2; ++mt) {
#pragma unroll
                    for (int ks = 0; ks < 2; ++ks) c1[mt][ks] = *(const LAS bf16x8*)(rp + CK_A1 + ((16 * mt + fr) * 64 + 32 * ks + 8 * q) * 2);
                    c2[mt] = *(const LAS bf16x8*)(rp + CK_A2 + ((16 * mt + fr) * 16 + 8 * (q & 1)) * 2); if (q >= 2) c2[mt] = zero8; }
#pragma unroll
                for (int kt = 0; kt < 4; ++kt) { c3[kt] = *(const LAS bf16x8*)(rp + CK_A3 + ((16 * kt + fr) * 32 + 8 * q) * 2); cg[kt] = *(const LAS pg8::f32x4*)(rp + CK_GC + (16 * kt + 4 * q) * 4); }
                cv8 = *(const LAS bf16x8*)(rp + CK_VT + ((16 * w + fr) * 16 + 8 * (q & 1)) * 2); if (q >= 2) cv8 = zero8;
                cv4 = *(const LAS v2u*)(rp + CK_VT + ((16 * w + fr) * 16 + 4 * q) * 2);
                bf16x8 sb[2];
#pragma unroll
                for (int ks = 0; ks < 2; ++ks) { const v2u lo = cvt4_bf16(st[2 * ks]), hi = cvt4_bf16(st[2 * ks + 1]); sb[ks] = __builtin_bit_cast(bf16x8, (v4u){lo.x, lo.y, hi.x, hi.y}); }
                pg8::f32x4 d[2];
#pragma unroll
                for (int mt = 0; mt < 2; ++mt) { d[mt] = (pg8::f32x4){0.f, 0.f, 0.f, 0.f};
                    d[mt] = __builtin_amdgcn_mfma_f32_16x16x32_bf16(c2[mt], cv8, d[mt], 0, 0, 0);
                    d[mt] = __builtin_amdgcn_mfma_f32_16x16x32_bf16(c1[mt][0], sb[0], d[mt], 0, 0, 0);
                    d[mt] = __builtin_amdgcn_mfma_f32_16x16x32_bf16(c1[mt][1], sb[1], d[mt], 0, 0, 0); }
#pragma unroll
                for (int r = 0; r < 4; ++r) ybuf[((s & 1) * 64 + c * 16 + 4 * q + r) * 64 + 16 * w + fr] = d[1][r];
                { const v2u ul = cvt4_bf16(d[0]); const bf16x8 ub = __builtin_bit_cast(bf16x8, (v4u){ul.x, ul.y, cv4.x, cv4.y});
#pragma unroll
                  for (int kt = 0; kt < 4; ++kt) { st[kt] = st[kt] * cg[kt]; st[kt] = __builtin_amdgcn_mfma_f32_16x16x32_bf16(c3[kt], ub, st[kt], 0, 0, 0); } }
            }
        }
          if (s + 1 < CK_NST) CS_STORE(rb, (s + 1) & 1);
          __syncthreads(); }
        { const int s = s2 + 1;
          if (s + 2 < CK_NST) CS_LOAD(rb, s + 2);
          CS_POST_RUN(s - 1); CS_POST_LOAD(s);
        if (w < 4) {
            for (int c = 0; c < 4; ++c) {
                const LAS unsigned char* rp = F.lds + (s & 1) * CK_STAGE + c * CK_BYTES;
                bf16x8 c1[2][2], c2[2], c3[4], cv8; v2u cv4; pg8::f32x4 cg[4];
#pragma unroll
                for (int mt = 0; mt < 2; ++mt) {
#pragma unroll
                    for (int ks = 0; ks < 2; ++ks) c1[mt][ks] = *(const LAS bf16x8*)(rp + CK_A1 + ((16 * mt + fr) * 64 + 32 * ks + 8 * q) * 2);
                    c2[mt] = *(const LAS bf16x8*)(rp + CK_A2 + ((16 * mt + fr) * 16 + 8 * (q & 1)) * 2); if (q >= 2) c2[mt] = zero8; }
#pragma unroll
                for (int kt = 0; kt < 4; ++kt) { c3[kt] = *(const LAS bf16x8*)(rp + CK_A3 + ((16 * kt + fr) * 32 + 8 * q) * 2); cg[kt] = *(const LAS pg8::f32x4*)(rp + CK_GC + (16 * kt + 4 * q) * 4); }
                cv8 = *(const LAS bf16x8*)(rp + CK_VT + ((16 * w + fr) * 16 + 8 * (q & 1)) * 2); if (q >= 2) cv8 = zero8;
                cv4 = *(const LAS v2u*)(rp + CK_VT + ((16 * w + fr) * 16 + 4 * q) * 2);
                bf16x8 sb[2];
#pragma unroll
                for (int ks = 0; ks < 2; ++ks) { const v2u lo = cvt4_bf16(st[2 * ks]), hi = cvt4_bf16(st[2 * ks + 1]); sb[ks] = __builtin_bit_cast(bf16x8, (v4u){lo.x, lo.y, hi.x, hi.y}); }
                pg8::f32x4 d[2];
#pragma unroll
                for (int mt = 0; mt < 2; ++mt) { d[mt] = (pg8::f32x4){0.f, 0.f, 0.f, 0.f};
                    d[mt] = __builtin_amdgcn_mfma_f32_16x16x32_bf16(c2[mt], cv8, d[mt], 0, 0, 0);
                    d[mt] = __builtin_amdgcn_mfma_f32_16x16x32_bf16(c1[mt][0], sb[0], d[mt], 0, 0, 0);
                    d[mt] = __builtin_amdgcn_mfma_f32_16x16x32_bf16(c1[mt][1], sb[1], d[mt], 0, 0, 0); }
#pragma unroll
                for (int r = 0; r < 4; ++r) ybuf[((s & 1) * 64 + c * 16 + 4 * q + r) * 64 + 16 * w + fr] = d[1][r];
                { const v2u ul = cvt4_bf16(d[0]); const bf16x8 ub = __builtin_bit_cast(bf16x8, (v4u){ul.x, ul.y, cv4.x, cv4.y});
#pragma unroll
                  for (int kt = 0; kt < 4; ++kt) { st[kt] = st[kt] * cg[kt]; st[kt] = __builtin_amdgcn_mfma_f32_16x16x32_bf16(c3[kt], ub, st[kt], 0, 0, 0); } }
            }
        }
          if (s + 1 < CK_NST) CS_STORE(ra, (s + 1) & 1);
          __syncthreads(); }
    }
    CS_POST_RUN(CK_NST - 1);
    __syncthreads();
#undef CS_POST_RUN
#undef CS_POST_LOAD
#undef CS_LOAD
#undef CS_STORE
}

constexpr int AT_KS = 0, AT_VT = 9216, AT_BUF = 18432, AT_LUT = 36864, AT_LUTP = 1032, AT_PS = 53376, AT_SEL = 118912, AT_UNI = 119424;
constexpr float AT_C = 0.125f * 1.4426950408889634f;
__device__ __forceinline__ int crow(int r, int h) { return (r & 3) + 8 * (r >> 2) + 4 * h; }

__device__ __forceinline__ void at_load(Frame& F, const bf16* kb, size_t ldk, const bf16* vb, size_t ldv, v4u& kw, v4u& vw) {
    const int r = F.tid >> 3, p = F.tid & 7;
    kw = *(const v4u*)(kb + (size_t)r * ldk + 8 * p);
    vw = *(const v4u*)(vb + (size_t)r * ldv + 8 * p);
}
template <bool VROWMAJOR> __device__ __forceinline__ void at_commit(Frame& F, const v4u& kw, const v4u& vw, int& nb) {
    const int r = F.tid >> 3, p = F.tid & 7; LAS unsigned char* bb = F.lds + (nb & 1) * AT_BUF; ++nb;
    *(LAS v4u*)(bb + AT_KS + (r * 72 + 8 * p) * 2) = kw;
    if (VROWMAJOR) {
        LAS bf16* vt = (LAS bf16*)(bb + AT_VT);
        vt[(8 * p + 0) * 72 + r] = (bf16)(vw.x & 0xffffu); vt[(8 * p + 1) * 72 + r] = (bf16)(vw.x >> 16);
        vt[(8 * p + 2) * 72 + r] = (bf16)(vw.y & 0xffffu); vt[(8 * p + 3) * 72 + r] = (bf16)(vw.y >> 16);
        vt[(8 * p + 4) * 72 + r] = (bf16)(vw.z & 0xffffu); vt[(8 * p + 5) * 72 + r] = (bf16)(vw.z >> 16);
        vt[(8 * p + 6) * 72 + r] = (bf16)(vw.w & 0xffffu); vt[(8 * p + 7) * 72 + r] = (bf16)(vw.w >> 16);
    } else {
        *(LAS v4u*)(bb + AT_VT + (r * 72 + 8 * p) * 2) = vw;
    }
    __syncthreads();
}
template <int BR> __device__ __forceinline__ void at_scores(Frame& F, const bf16x8 (&qf)[4], int kb0, int t, int hd, bool laneok, int path, int nb, int kt, f32x16& sc) {
    const int lane = F.lane, h = lane >> 5, r32 = lane & 31; const LAS unsigned char* bb = F.lds + ((nb - 1) & 1) * AT_BUF;
    const LAS float* lut = (const LAS float*)(F.lds + AT_LUT) + hd * AT_LUTP;
    f32x16 a;
#pragma unroll
    for (int i = 0; i < 16; ++i) a[i] = 0.f;
    bf16x8 kf[4];
#pragma unroll
    for (int s = 0; s < 4; ++s) kf[s] = *(const LAS bf16x8*)(bb + AT_KS + ((32 * kt + r32) * 72 + 16 * s + 8 * h) * 2);
    __builtin_amdgcn_sched_barrier(0);
#pragma unroll
    for (int s = 0; s < 4; ++s) a = __builtin_amdgcn_mfma_f32_32x32x16_bf16(kf[s], qf[s], a, 0, 0, 0);
    if (BR != 2 && path == 1) {
        const float add = laneok ? lut[1023] : -__builtin_inff();
#pragma unroll
        for (int r = 0; r < 16; ++r) sc[r] = a[r] * AT_C + add;
        return;
    }
    if (BR != 0 && path == 2) {
        const float neg = laneok ? 0.f : -__builtin_inff(); const LAS float* lq = lut + (t - kb0 - 32 * kt - 4 * h);
#pragma unroll
        for (int r = 0; r < 16; ++r) sc[r] = (a[r] * AT_C + lq[-((r & 3) + 8 * (r >> 2))]) + neg;
        return;
    }
#pragma unroll
    for (int r = 0; r < 16; ++r) {
        const int key = kb0 + 32 * kt + crow(r, h); const int dist = (BR == 0) ? t - 16 * key - 31 : t - key;
        int di = dist < 0 ? 0 : dist; di = di > 1023 ? 1023 : di;
        sc[r] = lut[di];
    }
    __builtin_amdgcn_sched_barrier(0);
#pragma unroll
    for (int r = 0; r < 16; ++r) {
        const int key = kb0 + 32 * kt + crow(r, h); int dist; bool ok;
        if (BR == 0) { dist = t - 16 * key - 31; ok = (dist >= 0) && (key < NCMP); }
        else if (BR == 1) { dist = t - key; ok = laneok && (dist >= 0); }
        else { dist = t - key; ok = (dist >= 0) && (dist < 512); }
        const float v = a[r] * AT_C + sc[r];
        sc[r] = ok ? v : -__builtin_inff();
    }
}
__device__ __forceinline__ bf16x8 pack8(const f32x16& x, int s) {
    v4u p; p.x = cvtpk(x[8 * s], x[8 * s + 1]); p.y = cvtpk(x[8 * s + 2], x[8 * s + 3]); p.z = cvtpk(x[8 * s + 4], x[8 * s + 5]); p.w = cvtpk(x[8 * s + 6], x[8 * s + 7]);
    return __builtin_bit_cast(bf16x8, p);
}
__device__ __forceinline__ void at_accum(Frame& F, f32x16& sc, float& m_run, float& l_run, f32x16 (&O)[2], int nb, int kt) {
    const int lane = F.lane, h = lane >> 5, r32 = lane & 31; const LAS unsigned char* bb = F.lds + ((nb - 1) & 1) * AT_BUF;
    bf16x8 vf[2][2];
#pragma unroll
    for (int s = 0; s < 2; ++s)
#pragma unroll
        for (int dt = 0; dt < 2; ++dt) { const LAS unsigned char* vp = bb + AT_VT + ((32 * dt + r32) * 72 + 32 * kt + 16 * s + 4 * h) * 2;
            const s16x4 lo = *(const LAS s16x4*)(vp), hi = *(const LAS s16x4*)(vp + 16); vf[s][dt] = __builtin_shufflevector(lo, hi, 0, 1, 2, 3, 4, 5, 6, 7); }
    __builtin_amdgcn_sched_barrier(0);
    float mx = -__builtin_inff();
#pragma unroll
    for (int r = 0; r < 16; ++r) mx = fmaxf(mx, sc[r]);
    mx = x32_max(mx);
    const float m_new = fmaxf(m_run, mx);
    const float alpha = __builtin_amdgcn_exp2f(m_run - m_new);
    float rs = 0.f;
#pragma unroll
    for (int r = 0; r < 16; ++r) { const float p = __builtin_amdgcn_exp2f(sc[r] - m_new); sc[r] = p; rs += p; }
    rs = x32_sum(rs);
    l_run = l_run * alpha + rs; m_run = m_new;
    if (__ballot(alpha != 1.f) != 0ull) {
#pragma unroll
        for (int dt = 0; dt < 2; ++dt)
#pragma unroll
            for (int i = 0; i < 16; ++i) O[dt][i] *= alpha;
    }
#pragma unroll
    for (int s = 0; s < 2; ++s) {
        bf16x8 pf = pack8(sc, s);
#pragma unroll
        for (int dt = 0; dt < 2; ++dt) O[dt] = __builtin_amdgcn_mfma_f32_32x32x16_bf16(vf[s][dt], pf, O[dt], 0, 0, 0);
    }
}
template <int MODE> __device__ __forceinline__ void at_finish(Frame& F, float gate, float l_run, f32x16 (&O)[2], LAS float* slab) {
    const float sc = l_run > 0.f ? gate / l_run : 0.f;
#pragma unroll
    for (int dt = 0; dt < 2; ++dt)
#pragma unroll
        for (int i = 0; i < 16; ++i) { LAS float* sp = slab + (dt * 16 + i) * NT; float v = (sc != 0.f) ? O[dt][i] * sc : 0.f;
            if (MODE != 0) v += *sp;
            if (MODE != 2) { *sp = v; O[dt][i] = 0.f; } else O[dt][i] = v; }
}
__device__ __forceinline__ void attn_unit(Frame& F, int b, int g, int qt) {
    unsigned char* ws = wsp(F); const int lane = F.lane, w = F.wave, tid = F.tid, h = lane >> 5, r32 = lane & 31;
    const bf16* Z = (const bf16*)(ws + WS_Z);
    const int t0 = 64 * qt, tl = r32 >> 2, hd = r32 & 3, t = t0 + 8 * w + tl;
    const size_t mrow = (size_t)b * SEQ + t;
    LAS float* ps = (LAS float*)(F.lds + AT_PS);
    LAS unsigned long long* selm = (LAS unsigned long long*)(F.lds + AT_SEL);
    LAS unsigned long long* unim = (LAS unsigned long long*)(F.lds + AT_UNI);
    __syncthreads();
    { const float* lut = (const float*)(ws + WS_LUT) + (size_t)(g * 4) * 1024; LAS float* ll = (LAS float*)(F.lds + AT_LUT);
#pragma unroll
      for (int i = 0; i < 2; ++i) { const int e = 4 * (tid + 512 * i); *(LAS f32x4*)(ll + e + (e >> 10) * (AT_LUTP - 1024)) = *(const f32x4*)(lut + e); }
#pragma unroll
      for (int i = 0; i < 8; ++i) *(LAS f32x4*)(ps + 4 * (tid + 512 * i)) = (f32x4){0.f, 0.f, 0.f, 0.f}; }
    bf16x8 qf[4];
#pragma unroll
    for (int s = 0; s < 4; ++s) qf[s] = *(const bf16x8*)(Z + mrow * ZW + ZC_Q + (g * 4 + hd) * 64 + 16 * s + 8 * h);
    const float* gt = (const float*)(ws + WS_GATES) + mrow * 24 + g * 12 + hd * 3;
    f32x16 O[2], sc; LAS float* slab = (LAS float*)(F.lds + AT_PS) + tid;
#pragma unroll
    for (int dt = 0; dt < 2; ++dt)
#pragma unroll
        for (int i = 0; i < 16; ++i) O[dt][i] = 0.f;
    float m_run = -1e30f, l_run = 0.f;
    const int tmax = t0 + 63; const int ncb = (tmax >= 31) ? (((tmax - 31) >> 4) >> 6) + 1 : 0;
    const bf16* KC = (const bf16*)(ws + WS_KC) + (size_t)(b * 2 + g) * 256 * 64; const bf16* VCT = (const bf16*)(ws + WS_VCT) + (size_t)(b * 2 + g) * 64 * 256;
    v4u kw, vw; int nb = 0;
    at_load(F, KC, 64, VCT, 256, kw, vw);
    for (int cb = 0; cb < ncb; ++cb) {
        at_commit<false>(F, kw, vw, nb);
        { const int nx = (cb + 1 < ncb) ? cb + 1 : 0; at_load(F, KC + (size_t)nx * 64 * 64, 64, VCT + nx * 64, 256, kw, vw); }
#pragma unroll
        for (int kt = 0; kt < 2; ++kt) { at_scores<0>(F, qf, cb * 64, t, hd, true, (t0 - 16 * (cb * 64 + 32 * kt + 31) - 31 >= 790 && cb * 64 + 32 * kt + 31 < NCMP) ? 1 : 0, nb, kt, sc); at_accum(F, sc, m_run, l_run, O, nb, kt); }
    }
    const float m_c = m_run, il_c = l_run > 0.f ? 1.f / l_run : 0.f;
    const float l_c = l_run;
    for (int cb = 0; cb < ncb; ++cb) {
        at_commit<false>(F, kw, vw, nb);
        if (cb + 1 < ncb) at_load(F, KC + (size_t)(cb + 1) * 64 * 64, 64, VCT + (cb + 1) * 64, 256, kw, vw);
#pragma unroll
        for (int kt = 0; kt < 2; ++kt) { at_scores<0>(F, qf, cb * 64, t, hd, true, (t0 - 16 * (cb * 64 + 32 * kt + 31) - 31 >= 790 && cb * 64 + 32 * kt + 31 < NCMP) ? 1 : 0, nb, kt, sc);
#pragma unroll
            for (int r = 0; r < 16; ++r) { float p = __builtin_amdgcn_exp2f(sc[r] - m_c) * il_c; p = sum4(p);
                if (hd == 0) ps[(8 * w + tl) * 256 + cb * 64 + 32 * kt + crow(r, h)] = p; } }
    }
    __syncthreads();
    unsigned long long myu = 0ull;
    for (int k = 0; k < 8; ++k) {
        const LAS float* pr = ps + (8 * w + k) * 256; const int j = lane;
        const f32x4 p4 = *(const LAS f32x4*)(pr + 4 * j); const float pm1 = (j > 0) ? pr[4 * j - 1] : 0.f;
        const float score = (p4.x + p4.y) + p4.z + 0.5f * (p4.w + pm1);
        const bool forced = (j == 0) || (j == qt) || (j == qt - 1);
        const float key = forced ? 1e4f : ((j <= qt) ? score : -1.f);
        const unsigned u = key < 0.f ? 0u : (__builtin_bit_cast(unsigned, key) + 1u);
        unsigned thr = 0u;
#pragma unroll
        for (int b = 31; b >= 0; --b) { const unsigned cand = thr | (1u << b); thr = (__popcll(__ballot(u >= cand)) >= 16) ? cand : thr; }
        const unsigned long long gt = __ballot(u > thr), eq = __ballot(u == thr);
        const int need = 16 - (int)__popcll(gt);
        const bool sel = (u > thr) || (u == thr && (int)__popcll(eq & ((1ull << j) - 1ull)) < need);
        const unsigned long long msk = __ballot(sel);
        if (lane == 0) selm[8 * w + k] = msk;
        myu |= msk;
    }
    if (lane == 0) unim[w] = myu;
    __syncthreads();
    at_finish<0>(F, sigmoidf_(gt[0]), l_c, O, slab);
    unsigned long long uni = 0ull;
#pragma unroll
    for (int k = 0; k < 8; ++k) uni |= unim[k];
    const unsigned long long mysel = selm[8 * w + tl];
    m_run = -1e30f; l_run = 0.f;
    { const bf16* KS = Z + (size_t)b * SEQ * ZW + ZC_KS + g * 64; const bf16* VS = Z + (size_t)b * SEQ * ZW + ZC_VS + g * 64;
      unsigned long long rem = uni & ((qt >= 63) ? ~0ull : ((1ull << (qt + 1)) - 1ull));
      int j = __builtin_ctzll(rem); rem &= rem - 1ull;
      at_load(F, KS + (size_t)j * 64 * ZW, ZW, VS + (size_t)j * 64 * ZW, ZW, kw, vw);
      for (;;) {
          at_commit<true>(F, kw, vw, nb);
          const bool more = rem != 0ull; int jn = 0;
          if (more) { jn = __builtin_ctzll(rem); rem &= rem - 1ull; at_load(F, KS + (size_t)jn * 64 * ZW, ZW, VS + (size_t)jn * 64 * ZW, ZW, kw, vw); }
          const bool mine = ((mysel >> j) & 1ull) != 0ull;
          if (__ballot(mine) != 0ull) {
              const int path = (j * 64 + 63 + 790 <= t0) ? 1 : ((j < qt) ? 2 : 0);
#pragma unroll
              for (int kt = 0; kt < 2; ++kt) { at_scores<1>(F, qf, j * 64, t, hd, mine, path, nb, kt, sc); at_accum(F, sc, m_run, l_run, O, nb, kt); }
          }
          if (!more) break;
          j = jn;
      } }
    at_finish<1>(F, sigmoidf_(gt[1]), l_run, O, slab);
    m_run = -1e30f; l_run = 0.f;
    { const bf16* KW = Z + (size_t)b * SEQ * ZW + ZC_KW + g * 64; const bf16* VW = Z + (size_t)b * SEQ * ZW + ZC_VW + g * 64;
      const int j0 = (qt >= 8 ? qt - 8 : 0);
      at_load(F, KW + (size_t)j0 * 64 * ZW, ZW, VW + (size_t)j0 * 64 * ZW, ZW, kw, vw);
      for (int j = j0; j <= qt; ++j) {
          at_commit<true>(F, kw, vw, nb);
          if (j < qt) at_load(F, KW + (size_t)(j + 1) * 64 * ZW, ZW, VW + (size_t)(j + 1) * 64 * ZW, ZW, kw, vw);
          const int path = (j < qt && j + 7 >= qt) ? 2 : 0;
#pragma unroll
          for (int kt = 0; kt < 2; ++kt) { at_scores<2>(F, qf, j * 64, t, hd, true, path, nb, kt, sc); at_accum(F, sc, m_run, l_run, O, nb, kt); }
      } }
    at_finish<2>(F, sigmoidf_(gt[2]), l_run, O, slab);
    bf16* yo = (bf16*)(ws + WS_YRW) + mrow * D + CW + (g * 4 + hd) * 64;
#pragma unroll
    for (int dt = 0; dt < 2; ++dt)
#pragma unroll
        for (int rg = 0; rg < 4; ++rg) { v2u o; o.x = pk2(O[dt][4 * rg], O[dt][4 * rg + 1]); o.y = pk2(O[dt][4 * rg + 2], O[dt][4 * rg + 3]); *(v2u*)(yo + 32 * dt + 8 * rg + 4 * h) = o; }
}
__device__ __forceinline__ void attn_phase(Frame& F, int l, int qbase = CW_Q) {
    LAS int* qslot = (LAS int*)(F.lds + XBASE + 1536);
    for (;;) {
        __syncthreads();
        if (F.tid == 0) *qslot = (int)__hip_atomic_fetch_add((unsigned*)(F.ctl + qbase + l * 64), 1u, RLX_AGENT);
        __syncthreads();
        const int u = *qslot;
        if (u >= 512) break;
        const int bg = u & 7, qt = 63 - (u >> 3);
        F.tid = tid_l(); F.lane = F.tid & 63; F.wave = __builtin_amdgcn_readfirstlane(F.tid >> 6);
        attn_unit(F, bg >> 1, bg & 1, qt);
    }
    __syncthreads();
}


struct Args { const float* in[34]; float* out; unsigned char* ws; };
__device__ __forceinline__ int moe_table(Frame& F, int l, LAS int* tb, LAS int* cn) {
    __syncthreads();
    if (F.tid < NEXP) cn[F.tid] = (int)__hip_atomic_load((unsigned*)(F.ctl + CW_CNT + (l * 32 + F.tid) * 64), RLX_AGENT);
    __syncthreads();
    if (F.tid == 0) { int run = 0; for (int e = 0; e < NEXP; ++e) { tb[e] = run; run += (cn[e] + 255) >> 8; } tb[NEXP] = run; }
    __syncthreads();
    return tb[NEXP];
}
__device__ __forceinline__ int gin_panel(Frame& F) { pg8::StaticOrder S0; S0.init(M, ZW, F.G, bid_l()); pg8::Unit u0; (void)S0.next(0, u0); return __builtin_amdgcn_readfirstlane(u0.pm); }
__device__ __forceinline__ int my_panel(Frame& F) { pg8::StaticOrder S0; S0.init(M, D, F.G, bid_l()); pg8::Unit u0; (void)S0.next(0, u0); return __builtin_amdgcn_readfirstlane(u0.pm); }
__global__ void __launch_bounds__(NT, 2) fwd(Args args) {
    extern __shared__ __attribute__((aligned(16))) unsigned char lds[];
    Frame F;
    F.lds = (LAS unsigned char*)lds;
    F.tid = threadIdx.x; F.lane = F.tid & 63; F.wave = __builtin_amdgcn_readfirstlane(F.tid >> 6);
    F.G = gridDim.x; { const int bx = blockIdx.x; F.bid = bx; F.vcu = (bx % 8) * (F.G / 8) + bx / 8; }
    F.ws = args.ws; F.ctl = (gu32*)(args.ws + WS_CTL);
    unsigned char* ws = args.ws;
    for (int u = F.tid; u < (LDS_BYTES - RING_BYTES) / 4; u += NT) ((LAS unsigned*)(F.lds + RING_BYTES))[u] = 0u;
    __syncthreads();
    if (F.lane == 0) ((LAS int*)(F.lds + WSLOT_OFF))[(unsigned)__builtin_amdgcn_s_getreg((6 << 11) | 4) & 63u] = F.wave;
    if (F.tid == 0) {
#pragma unroll
        for (int k = 0; k < 34; ++k) ((LAS unsigned long long*)(F.lds + TAB_OFF))[k] = (unsigned long long)args.in[k]; }
    __syncthreads();
    (void)xcd_barrier_post((unsigned*)(F.ctl + CW_BAR), (volatile LAS unsigned*)(F.lds + MISC_OFF) + 8);
    LAS int* tb = (LAS int*)(F.lds + XBASE + 1024); LAS int* cn = (LAS int*)(F.lds + XBASE + 1280);
#define GRID_BAR() do { { XcdBarrier b2_; b2_.bar = (unsigned*)((gu32*)(wsp(F) + WS_CTL) + CW_BAR); b2_.x = xb_xcc_id(); b2_.st = (volatile LAS unsigned*)(F.lds + MISC_OFF) + 8; xcd_barrier(b2_); } F.tid = tid_l(); F.lane = F.tid & 63; F.wave = __builtin_amdgcn_readfirstlane(F.tid >> 6); { const int bx = bid_l(); F.bid = bx; F.vcu = (bx % 8) * (F.G / 8) + bx / 8; } } while (0)

#define PANEL_SIGNAL(l_, st_, pm_) do { asm volatile("s_waitcnt vmcnt(0)" ::: "memory"); __syncthreads(); if (F.tid == 0) (void)__hip_atomic_fetch_add((unsigned*)(F.ctl + CW_PANEL + (((l_) * 4 + (st_)) * 64 + (pm_)) * 64), 1u, RLX_AGENT); } while (0)
#define PANEL_WAIT(l_, st_, pm_) do { if (F.tid == 0) { unsigned* p_ = (unsigned*)(F.ctl + CW_PANEL + (((l_) * 4 + (st_)) * 64 + (pm_)) * 64); unsigned sp_ = 0u; \
            while (xb_ld(p_) < 4u) { __builtin_amdgcn_s_sleep(1); if (++sp_ > XB_SPIN_CAP) break; } \
            __builtin_amdgcn_fence(__ATOMIC_ACQUIRE, "agent"); asm volatile("s_waitcnt vmcnt(0)" ::: "memory"); } \
        __syncthreads(); F.tid = tid_l(); F.lane = F.tid & 63; F.wave = __builtin_amdgcn_readfirstlane(F.tid >> 6); { const int bx = bid_l(); F.bid = bx; F.vcu = (bx % 8) * (F.G / 8) + bx / 8; } } while (0)

#define PANEL_WAIT4(l_, st_, a_, b_, c_, d_) do { if (F.tid == 0) { const int pl_[4] = {(a_), (b_), (c_), (d_)}; \
            _Pragma("unroll") for (int i_ = 0; i_ < 4; ++i_) { unsigned* p_ = (unsigned*)(F.ctl + CW_PANEL + (((l_) * 4 + (st_)) * 64 + pl_[i_]) * 64); unsigned sp_ = 0u; \
                while (xb_ld(p_) < 4u) { __builtin_amdgcn_s_sleep(1); if (++sp_ > XB_SPIN_CAP) break; } } \
            __builtin_amdgcn_fence(__ATOMIC_ACQUIRE, "agent"); asm volatile("s_waitcnt vmcnt(0)" ::: "memory"); } \
        __syncthreads(); F.tid = tid_l(); F.lane = F.tid & 63; F.wave = __builtin_amdgcn_readfirstlane(F.tid >> 6); { const int bx = bid_l(); F.bid = bx; F.vcu = (bx % 8) * (F.G / 8) + bx / 8; } } while (0)

#define QUAD_WORD(l_, q_) (CW_PANEL + 65536 + ((l_) * 64 + (q_)) * 64)
#define MOE1_DONE_WORD(l_) (CW_PANEL + 65536 + (4 * 64 + (l_)) * 64)
#define CTR_WAIT(word_, need_, acq_) do { if (F.tid == 0) { unsigned* p_ = (unsigned*)(F.ctl + (word_)); unsigned sp_ = 0u; \
            while (xb_ld(p_) < (unsigned)(need_)) { __builtin_amdgcn_s_sleep(1); if (++sp_ > XB_SPIN_CAP) break; } \
            if (acq_) { __builtin_amdgcn_fence(__ATOMIC_ACQUIRE, "agent"); asm volatile("s_waitcnt vmcnt(0)" ::: "memory"); } } \
        __syncthreads(); F.tid = tid_l(); F.lane = F.tid & 63; F.wave = __builtin_amdgcn_readfirstlane(F.tid >> 6); { const int bx = bid_l(); F.bid = bx; F.vcu = (bx % 8) * (F.G / 8) + bx / 8; } } while (0)

    F.tid = tid_l(); F.lane = F.tid & 63; F.wave = __builtin_amdgcn_readfirstlane(F.tid >> 6);
    lut_phase(F);
    wsmall_phase(F);
    ln_phase<0>(F, 0, nullptr);
    conv_phase<1>(F, 0, 0);
    conv_small(F, 0);
    GRID_BAR();
    int prev_total = 0;
    for (int l = 0; l < DEPTH; ++l) {
        F.tid = tid_l(); F.lane = F.tid & 63; F.wave = __builtin_amdgcn_readfirstlane(F.tid >> 6);
        { unsigned char* ws = wsp(F); float* S0 = (float*)(ws + WS_S); (void)S0; pg8::Gemm g{(const bf16*)(ws + WS_XB), (const bf16*)(ws + WS_WIN), M, ZW, D}; pg8::StaticOrder S; S.init(M, ZW, F.G, bid_l());
          EpiBf16Store E{(bf16*)(ws + WS_Z), ZW, (bf16*)(ws + WS_CMP), (bf16*)(ws + WS_LOR)};
          pg8::gemm_phase<EpiBf16Store, pg8::StaticOrder, false>(F.lds, g, S, E); }
        PANEL_SIGNAL(l, 2, gin_panel(F));
        { const int bx = bid_l(), own = bx >> 2, prv = ((bx & 3) == 0 && (bx & 63) != 0) ? own - 1 : own, c0 = (bx >> 6) * 16 + ((bx >> 1) & 15), c1 = ((bx >> 1) & 15) < 15 ? c0 + 1 : c0;
          PANEL_WAIT4(l, 2, own, prv, c0, c1); }
        prep_unit(F, l, F.bid);
        compress_unit(F, F.bid);
        asm volatile("s_waitcnt vmcnt(0)" ::: "memory"); __syncthreads();
        chunk_prep(F, l, inp(F, 4) + (size_t)l * CW, inp(F, 6) + (size_t)l * CW, inp(F, 10) + (size_t)l * CW);
        GRID_BAR();
        chunk_scan(F, l);
        if (F.bid >= 32 && F.bid < 64) { if (l == 0) conv_phase<2>(F, 0, 0); else conv_phase<3>(F, l, prev_total); __syncthreads(); }
        attn_phase(F, l);
        GRID_BAR();
        { unsigned char* ws = wsp(F); pg8::Gemm g{(const bf16*)(ws + WS_YRW), (const bf16*)(ws + WS_WUPR), M, D, D}; pg8::StaticOrder S; S.init(M, D, F.G, bid_l());
          EpiUpM E{(const bf16*)(ws + WS_Z), (bf16*)(ws + WS_MERGED)};
          pg8::gemm_phase<EpiUpM, pg8::StaticOrder, false>(F.lds, g, S, E); }
        PANEL_SIGNAL(l, 0, my_panel(F));
        { unsigned char* ws = wsp(F); float* S0 = (float*)(ws + WS_S); (void)S0; pg8::Gemm g{(const bf16*)(ws + WS_MERGED), (const bf16*)(ws + WS_WOUT), M, D, D}; pg8::StaticOrder S; S.init(M, D, F.G, bid_l());
          EpiOut E{(const bf16*)(ws + WS_XB), (bf16*)(ws + WS_S + 64 * MiB)};
          auto pre = [&]() { PANEL_WAIT(l, 0, my_panel(F)); };
          pg8::gemm_phase<EpiOut, pg8::StaticOrder, false>(F.lds, g, S, E, pre); }
        PANEL_SIGNAL(l, 1, my_panel(F));
        PANEL_WAIT(l, 1, F.bid >> 2);
        ln_phase<1>(F, l, nullptr);
        if (l + 1 < DEPTH) conv_small(F, l + 1);
        GRID_BAR();
        const int total = moe_table(F, l, tb, cn);
        { unsigned char* ws = wsp(F); float* S0 = (float*)(ws + WS_S); (void)S0; pg8::Gemm g{(const bf16*)(ws + WS_XB), (const bf16*)(ws + WS_W13), M, D, D};
          MoeOrder S{tb, cn, (const unsigned*)(ws + WS_LISTS), F.G, F.vcu, total, (size_t)1024 * 1024 * 2};
          EpiMoe1 E{(bf16*)(ws + WS_S + 128 * MiB)};
          pg8::gemm_phase<EpiMoe1, MoeOrder, true>(F.lds, g, S, E); }
        __syncthreads(); if (F.tid == 0) { (void)__hip_atomic_fetch_add((unsigned*)(F.ctl + QUAD_WORD(l, F.vcu >> 2)), 1u, RLX_AGENT); (void)__hip_atomic_fetch_add((unsigned*)(F.ctl + MOE1_DONE_WORD(l)), 1u, RLX_AGENT); }
        if (l + 1 < DEPTH) conv_tail(F, l + 1, total, 0);
        __syncthreads();
        { unsigned char* ws = wsp(F); float* S0 = (float*)(ws + WS_S); (void)S0; pg8::Gemm g{(const bf16*)(ws + WS_S + 128 * MiB), (const bf16*)(ws + ws_w2(l)), total * 256, D, DEXP};
          MoeOrder S{tb, cn, (const unsigned*)(ws + WS_LISTS), F.G, F.vcu, total, (size_t)1024 * 512 * 2};
          EpiMoe2 E{(bf16*)(ws + WS_YS), (const unsigned*)(ws + WS_LISTS), (const float*)(ws + WS_WLIST)};
          auto pre = [&]() { CTR_WAIT(QUAD_WORD(l, F.vcu >> 2), 4, true); };
          pg8::gemm_phase<EpiMoe2, MoeOrder, false>(F.lds, g, S, E, pre); }
        if (l + 1 < DEPTH) { CTR_WAIT(MOE1_DONE_WORD(l), 256, false); conv_tail(F, l + 1, total, 1); }
        GRID_BAR();
        ln_phase<2>(F, l, l == DEPTH - 1 ? (float*)(GAS float*)args.out : nullptr);
        if (l + 1 < DEPTH) PANEL_SIGNAL(l, 3, F.bid >> 2);
        if (l + 1 < DEPTH) conv_phase<0>(F, l + 1, total);
        prev_total = total;
        if (l + 1 < DEPTH) {
            const int rem_ = (total * 4) & 255;
            if (rem_ != 0 && (256 - rem_) * 64 >= CV_CAT0) PANEL_WAIT(l, 3, gin_panel(F)); else GRID_BAR();
        }
    }
#undef GRID_BAR
}

extern "C" void kernel_launch(void* const* d_in, const int* in_sizes, int n_in, void* d_out, int out_size, void* d_ws, size_t ws_size, hipStream_t stream) {
    static int grid = 0;
    if (grid == 0) {
        if (n_in != 34 || in_sizes[0] != M * D || out_size != M * D || ws_size < WS_END) { fprintf(stderr, "kernel_launch: unexpected problem: n_in %d in0 %d out %d ws %zu (need %zu)\n", n_in, n_in > 0 ? in_sizes[0] : -1, out_size, ws_size, (size_t)WS_END); grid = -1; return; }
        int dev = 0, cus = 0, per_cu = 0;
        if (hipGetDevice(&dev) != hipSuccess || hipDeviceGetAttribute(&cus, hipDeviceAttributeMultiprocessorCount, dev) != hipSuccess) { grid = -1; return; }
        if (hipFuncSetAttribute((const void*)fwd, hipFuncAttributeMaxDynamicSharedMemorySize, LDS_BYTES) != hipSuccess) { fprintf(stderr, "kernel_launch: hipFuncSetAttribute failed\n"); grid = -1; return; }
        if (hipOccupancyMaxActiveBlocksPerMultiprocessor(&per_cu, (const void*)fwd, NT, LDS_BYTES) != hipSuccess || per_cu < 1) fprintf(stderr, "kernel_launch: occupancy query reports %d\n", per_cu);
        (void)hipGetLastError();
        if (cus < 256) { fprintf(stderr, "kernel_launch: %d CUs < 256\n", cus); grid = -1; return; }
        grid = 256;
    }
    if (grid < 0) return;
    if (hipMemsetAsync((char*)d_ws + WS_CTL, 0, CTL_ZERO_BYTES, stream) != hipSuccess) return;
    Args a{};
    for (int i = 0; i < 34; ++i) a.in[i] = (const float*)d_in[i];
    a.out = (float*)d_out; a.ws = (unsigned char*)d_ws;
    hipLaunchKernelGGL(fwd, dim3(grid), dim3(NT), LDS_BYTES, stream, a);
}
```
